# Optimizing an MI355X kernel written in HIP

```python
import jax, jax.numpy as jnp
from jax import lax
import numpy as np

D_MODEL = 1024
BATCH = 16
SEQ = 2048
DEPTH = 1
DEC_BATCH = 128
DEC_SEQ = 1
PAST_LEN = 16384
PAGE_SIZE = 128

CHUNK = 128
GM_HEADS = 8
GM_DIM = D_MODEL // 2 // GM_HEADS
GM_WIDTH = GM_HEADS * GM_DIM
N_HEADS = 8
KV_HEADS = 2
HEAD_DIM = 64
GROUP = N_HEADS // KV_HEADS
WINDOW = 128
ATT_BLOCK = 128
ROPE_THETA = 10000.0
Q_WIDTH = N_HEADS * HEAD_DIM
KV_WIDTH = KV_HEADS * HEAD_DIM
D_FF = 3 * D_MODEL
CONV_W = 3
EPS = 1e-6
IN_WIDTH = 2 * GM_WIDTH + Q_WIDTH + 2 * KV_WIDTH + 2 * D_MODEL

kernel_name = 'hybrid_gmlp_swa_sink_convffn_step'


def rms_norm(x, g):
    xf = x.astype(jnp.float32)
    y = xf * lax.rsqrt(jnp.mean(xf * xf, axis=-1, keepdims=True) + EPS)
    return (y * g.astype(jnp.float32)).astype(x.dtype)


def layer_norm(x, g, b):
    xf = x.astype(jnp.float32)
    mu = jnp.mean(xf, axis=-1, keepdims=True)
    var = jnp.mean(jnp.square(xf - mu), axis=-1, keepdims=True)
    y = (xf - mu) * lax.rsqrt(var + EPS)
    return (y * g.astype(jnp.float32) + b.astype(jnp.float32)).astype(x.dtype)


def rotary(x, pos):
    half = HEAD_DIM // 2
    inv = ROPE_THETA ** (-jnp.arange(half, dtype=jnp.float32) / half)
    ang = pos.astype(jnp.float32)[:, None] * inv[None, :]
    cos = jnp.cos(ang)[None, :, None, :]
    sin = jnp.sin(ang)[None, :, None, :]
    xf = x.astype(jnp.float32)
    x1, x2 = xf[..., :half], xf[..., half:]
    return jnp.concatenate([x1 * cos - x2 * sin, x2 * cos + x1 * sin], axis=-1).astype(x.dtype)


def sink_softmax(s, mask, sink):
    s = jnp.where(mask, s, -jnp.inf)
    sink = sink.astype(jnp.float32)
    m = jnp.maximum(jnp.max(s, axis=-1, keepdims=True), sink)
    p = jnp.exp(s - m)
    return p / (jnp.sum(p, axis=-1, keepdims=True) + jnp.exp(sink - m))


def in_projection(h, w_in, ln_v_g, ln_v_b):
    B, S = h.shape[0], h.shape[1]
    z = h @ w_in
    a = jax.nn.gelu(z[..., :2 * GM_WIDTH])
    u = a[..., :GM_WIDTH]
    vg = layer_norm(a[..., GM_WIDTH:], ln_v_g, ln_v_b).reshape(B, S, GM_HEADS, GM_DIM)
    o = 2 * GM_WIDTH
    q = z[..., o:o + Q_WIDTH].reshape(B, S, N_HEADS, HEAD_DIM)
    o += Q_WIDTH
    k = z[..., o:o + KV_WIDTH].reshape(B, S, KV_HEADS, HEAD_DIM)
    o += KV_WIDTH
    v = z[..., o:o + KV_WIDTH].reshape(B, S, KV_HEADS, HEAD_DIM)
    o += KV_WIDTH
    ga = z[..., o:o + D_MODEL]
    gb = z[..., o + D_MODEL:]
    return u, vg, q, k, v, ga, gb


def spatial_gate(u, vg, w_s, b_s):
    B, S = u.shape[0], u.shape[1]
    T = min(S, CHUNK)
    nc = S // T
    causal = jnp.tril(jnp.ones((T, T), dtype=bool))
    ws = jnp.where(causal[None], w_s[:, :T, :T], 0.0).astype(vg.dtype)
    vc = vg.reshape(B, nc, T, GM_HEADS, GM_DIM)
    mix = jnp.einsum('hts,bcshd->bcthd', ws, vc) + b_s[:, :T].T[:, :, None].astype(vg.dtype)
    return u * mix.reshape(B, S, GM_WIDTH)


def swa_prompt(q, k, v, sinks):
    B, S = q.shape[0], q.shape[1]
    T = ATT_BLOCK
    nb = S // T
    qb = q.reshape(B, nb, T, KV_HEADS, GROUP, HEAD_DIM)
    kb = k.reshape(B, nb, T, KV_HEADS, HEAD_DIM)
    vb = v.reshape(B, nb, T, KV_HEADS, HEAD_DIM)
    kprev = jnp.concatenate([jnp.zeros_like(kb[:, :1]), kb[:, :-1]], axis=1)
    vprev = jnp.concatenate([jnp.zeros_like(vb[:, :1]), vb[:, :-1]], axis=1)
    kk = jnp.concatenate([kprev, kb], axis=2)
    vv = jnp.concatenate([vprev, vb], axis=2)
    s = jnp.einsum('bcqhgd,bckhd->bchgqk', qb, kk).astype(jnp.float32) * (HEAD_DIM ** -0.5)
    i = jnp.arange(T)[:, None]
    j = jnp.arange(2 * T)[None, :]
    diff = i + T - j
    band = (diff >= 0) & (diff <= WINDOW)
    blk = jnp.arange(nb)[:, None, None]
    mask = band[None] & ((blk > 0) | (j >= T)[None])
    sink = sinks.reshape(KV_HEADS, GROUP)[None, None, :, :, None, None]
    p = sink_softmax(s, mask[None, :, None, None], sink)
    o = jnp.einsum('bchgqk,bckhd->bcqhgd', p.astype(vv.dtype), vv)
    return o.reshape(B, S, Q_WIDTH)


def swa_sample(q, k_new, v_new, cache_k, cache_v, sinks):
    Bd, n = q.shape[0], q.shape[1]
    W = cache_k.shape[1]
    kk = jnp.concatenate([cache_k.astype(k_new.dtype), k_new], axis=1)
    vv = jnp.concatenate([cache_v.astype(v_new.dtype), v_new], axis=1)
    qpos = PAST_LEN + jnp.arange(n)
    kpos = jnp.concatenate([PAST_LEN - W + jnp.arange(W), qpos])
    diff = qpos[:, None] - kpos[None, :]
    mask = (diff >= 0) & (diff <= WINDOW)
    qg = q.reshape(Bd, n, KV_HEADS, GROUP, HEAD_DIM)
    s = jnp.einsum('bqhgd,bkhd->bhgqk', qg, kk).astype(jnp.float32) * (HEAD_DIM ** -0.5)
    sink = sinks.reshape(KV_HEADS, GROUP)[None, :, :, None, None]
    p = sink_softmax(s, mask, sink)
    o = jnp.einsum('bhgqk,bkhd->bqhgd', p.astype(vv.dtype), vv).reshape(Bd, n, Q_WIDTH)
    return o, kk[:, -W:], vv[:, -W:]


def conv_ffn(h, prefix, w_up, conv_w, conv_b, w_down):
    S = h.shape[1]
    z = h @ w_up
    zc = jnp.concatenate([prefix.astype(z.dtype), z], axis=1)
    c = conv_b
    for t in range(CONV_W):
        c = c + conv_w[t] * zc[:, t:t + S]
    y = (jax.nn.gelu(c[..., :D_FF]) * c[..., D_FF:]) @ w_down
    return y, zc[:, -(CONV_W - 1):]


def decoder_layer(x, pos, wl, cache_k, cache_v, conv_state):
    (g_mix, w_in, ln_v_g, ln_v_b, w_s, b_s, sinks, w_pa, w_pb, w_o,
     g_ffn, w_up, conv_w, conv_b, w_down) = wl
    B, S = x.shape[0], x.shape[1]
    h = rms_norm(x, g_mix)
    u, vg, q, k, v, ga, gb = in_projection(h, w_in, ln_v_g, ln_v_b)
    q = rotary(q, pos)
    k = rotary(k, pos)
    y_a = spatial_gate(u, vg, w_s, b_s)
    last = S - ((S - 1) // CHUNK) * CHUNK
    gm_rows = vg[:, S - last:]
    if cache_k is None:
        y_b = swa_prompt(q, k, v, sinks)
        keep = min(WINDOW, S)
        new_k, new_v = k[:, S - keep:], v[:, S - keep:]
        prefix = jnp.zeros((B, CONV_W - 1, 2 * D_FF), dtype=x.dtype)
    else:
        y_b, new_k, new_v = swa_sample(q, k, v, cache_k, cache_v, sinks)
        prefix = conv_state
    merged = jax.nn.sigmoid(ga) * (y_a @ w_pa) + jax.nn.sigmoid(gb) * (y_b @ w_pb)
    x = x + merged @ w_o
    y_f, new_conv = conv_ffn(rms_norm(x, g_ffn), prefix, w_up, conv_w, conv_b, w_down)
    x = x + y_f
    return x, new_k, new_v, gm_rows, new_conv


def setup_inputs(seed: int = 0) -> dict:
    key = jax.random.key(seed)
    ks = jax.random.split(key, 24)
    f32 = jnp.float32
    w_buf = min(WINDOW, PAST_LEN)
    nrm = lambda k, shape, s: jax.random.normal(k, shape, f32) * s
    return {
        'x_prompt': nrm(ks[0], (BATCH, SEQ, D_MODEL), 1.0),
        'x_sample': nrm(ks[1], (DEC_BATCH, DEC_SEQ, D_MODEL), 1.0),
        'cache_swa_k': nrm(ks[2], (DEPTH, DEC_BATCH, w_buf, KV_HEADS, HEAD_DIM), 1.0),
        'cache_swa_v': nrm(ks[3], (DEPTH, DEC_BATCH, w_buf, KV_HEADS, HEAD_DIM), 1.0),
        'state_ffn_conv': nrm(ks[4], (DEPTH, DEC_BATCH, CONV_W - 1, 2 * D_FF), 1.0),
        'g_mix': 1.0 + nrm(ks[5], (DEPTH, D_MODEL), 0.05),
        'w_in': nrm(ks[6], (DEPTH, D_MODEL, IN_WIDTH), D_MODEL ** -0.5),
        'ln_v_g': 1.0 + nrm(ks[7], (DEPTH, GM_WIDTH), 0.05),
        'ln_v_b': nrm(ks[8], (DEPTH, GM_WIDTH), 0.02),
        'w_s': nrm(ks[9], (DEPTH, GM_HEADS, CHUNK, CHUNK), CHUNK ** -0.5),
        'b_s': 1.0 + nrm(ks[10], (DEPTH, GM_HEADS, CHUNK), 0.1),
        'sinks': nrm(ks[11], (DEPTH, N_HEADS), 0.5),
        'w_pa': nrm(ks[12], (DEPTH, GM_WIDTH, D_MODEL), GM_WIDTH ** -0.5),
        'w_pb': nrm(ks[13], (DEPTH, Q_WIDTH, D_MODEL), Q_WIDTH ** -0.5),
        'w_o': nrm(ks[14], (DEPTH, D_MODEL, D_MODEL), D_MODEL ** -0.5),
        'g_ffn': 1.0 + nrm(ks[15], (DEPTH, D_MODEL), 0.05),
        'w_up': nrm(ks[16], (DEPTH, D_MODEL, 2 * D_FF), D_MODEL ** -0.5),
        'conv_w': nrm(ks[17], (DEPTH, CONV_W, 2 * D_FF), CONV_W ** -0.5),
        'conv_b': nrm(ks[18], (DEPTH, 2 * D_FF), 0.02),
        'w_down': nrm(ks[19], (DEPTH, D_FF, D_MODEL), D_FF ** -0.5),
        'g_final': 1.0 + nrm(ks[20], (D_MODEL,), 0.05),
    }


def reference(x_prompt, x_sample, cache_swa_k, cache_swa_v, state_ffn_conv,
              g_mix, w_in, ln_v_g, ln_v_b, w_s, b_s, sinks, w_pa, w_pb, w_o,
              g_ffn, w_up, conv_w, conv_b, w_down, g_final):
    xp, xs = x_prompt, x_sample
    pos_p = jnp.arange(xp.shape[1], dtype=jnp.int32)
    pos_s = PAST_LEN + jnp.arange(xs.shape[1], dtype=jnp.int32)
    kp_l, vp_l, ap_l, cp_l = [], [], [], []
    ks_l, vs_l, as_l, cs_l = [], [], [], []
    for l in range(DEPTH):
        wl = (g_mix[l], w_in[l], ln_v_g[l], ln_v_b[l], w_s[l], b_s[l], sinks[l],
              w_pa[l], w_pb[l], w_o[l], g_ffn[l], w_up[l], conv_w[l], conv_b[l], w_down[l])
        xp, kp, vp, ap, cp = decoder_layer(xp, pos_p, wl, None, None, None)
        xs, ksn, vsn, asn, csn = decoder_layer(xs, pos_s, wl, cache_swa_k[l], cache_swa_v[l], state_ffn_conv[l])
        kp_l.append(kp); vp_l.append(vp); ap_l.append(ap); cp_l.append(cp)
        ks_l.append(ksn); vs_l.append(vsn); as_l.append(asn); cs_l.append(csn)
    y_prompt = rms_norm(xp, g_final)
    y_sample = rms_norm(xs, g_final)
    new_swa_k_prompt = jnp.stack(kp_l, axis=0)
    new_swa_v_prompt = jnp.stack(vp_l, axis=0)
    new_gm_v_prompt = jnp.stack(ap_l, axis=0)
    new_conv_prompt = jnp.stack(cp_l, axis=0)
    new_swa_k_sample = jnp.stack(ks_l, axis=0)
    new_swa_v_sample = jnp.stack(vs_l, axis=0)
    new_gm_v_sample = jnp.stack(as_l, axis=0)
    new_conv_sample = jnp.stack(cs_l, axis=0)
    return (y_prompt, y_sample, new_swa_k_prompt, new_swa_v_prompt, new_gm_v_prompt, new_conv_prompt,
            new_swa_k_sample, new_swa_v_sample, new_gm_v_sample, new_conv_sample)
```

```cpp
#include <hip/hip_runtime.h>
#include <hip/hip_cooperative_groups.h>
#include <cstdio>
#include <cstdint>
namespace cg = cooperative_groups;
namespace pg8 {
#define PG8_LAS __attribute__((address_space(3)))
typedef unsigned short bf16_t;
typedef short bf16x8 __attribute__((ext_vector_type(8)));
typedef float f32x4 __attribute__((ext_vector_type(4)));
typedef unsigned u32x4 __attribute__((ext_vector_type(4)));
constexpr int BM = 256, BK = 64, HALF = 128, HTB = HALF * BK * 2  , STAGE_BYTES = 8 * HTB, NXCD = 8, WGM = 8;

__host__ __device__ __forceinline__ int lds_byte(int r, int c) { const int st = (r >> 4) * 2 + (c >> 5), rr = r & 15, cc = c & 31, ob = rr * 64 + cc * 2; return st * 1024 + (ob ^ (((ob >> 9) & 1) << 5)); }
__host__ __device__ __forceinline__ void stage_rc(int b, int& R, int& C) { const int st = b / 1024, sb = b % 1024, swz = sb ^ (((sb >> 9) & 1) << 5); R = (st >> 1) * 16 + swz / 64; C = (st & 1) * 32 + (swz % 64) / 2; }
__host__ __device__ __forceinline__ int perm32(int rho) { const int n = rho >> 4, i = rho & 15; return 8 * (i >> 2) + 4 * n + (i & 3); }

struct Unit { int pm, pn, kh; };
struct Gemm { const bf16_t* A; const bf16_t* Bt; int M, N, K; int lda, ldb; };

struct StaticOrder {
    int nM, nN, nwg, G, c;
    __host__ __device__ void init(int M, int N, int G_, int c_) { nM = M / BM; nN = N / BM; nwg = nM * nN; G = G_; c = c_; }
    __host__ __device__ bool next(int i, Unit& u) const {
        const long L = (long)i * G + c; if (L >= nwg) return false;
        int wgid = (int)L; { const int q = nwg / NXCD, r = nwg % NXCD, xcd = wgid % NXCD, off = wgid / NXCD; wgid = (xcd < r ? xcd * (q + 1) : r * (q + 1) + (xcd - r) * q) + off; }
        const int nig = WGM * nN, gid = wgid / nig, fm = gid * WGM, gsz = (nM - fm) < WGM ? (nM - fm) : WGM;
        u.pm = fm + ((wgid % nig) % gsz); u.pn = (wgid % nig) / gsz; u.kh = 0; return true;
    }
    __device__ __forceinline__ void a_ready(const Unit&) const {}
    __device__ __forceinline__ void done(const Unit&) const {}
};
struct SplitOrder {
    StaticOrder b;
    __host__ __device__ void init(int M, int N, int G_, int c_) { b.init(M, N, G_, c_); }
    __host__ __device__ bool next(int i, Unit& u) const { if (!b.next(i >> 1, u)) return false; u.kh = i & 1; return true; }
    __device__ __forceinline__ void a_ready(const Unit&) const {}
    __device__ __forceinline__ void done(const Unit&) const {}
};
__device__ __forceinline__ unsigned cvt_pk_bf16(float lo, float hi) { unsigned r; asm volatile("v_cvt_pk_bf16_f32 %0, %1, %2" : "=v"(r) : "v"(lo), "v"(hi)); return r; }
typedef float f32x2 __attribute__((ext_vector_type(2)));
template <class Epi, class Sched, bool ALIGN_EPI = false, bool SP2 = false>
__device__ __forceinline__ void gemm_phase(PG8_LAS unsigned char* lds, const Gemm g, const Sched& S, const Epi& E) {
    const int tid = threadIdx.x, wid = __builtin_amdgcn_readfirstlane(tid >> 6), lane = tid & 63, wr = wid >> 2, wc = wid & 3, fr = lane & 15, fq = lane >> 4;
    const int K = g.K, nt = K / BK;
    const int lda = g.lda ? g.lda : K, ldb = g.ldb ? g.ldb : K;
    unsigned voffA[2], voffB[2];
#pragma unroll
    for (int i = 0; i < 2; ++i) { int R, C; stage_rc(tid * 16 + i * 8192, R, C); const int Rb = Epi::PERM ? ((R & ~31) + perm32(R & 31)) : R;
        voffA[i] = (unsigned)(R * lda + C) * 2u; voffB[i] = (unsigned)(Rb * ldb + C) * 2u; }
    const size_t kstep = (size_t)(BK * 2);
    const size_t hstepA = (size_t)HALF * lda * 2, hstepB = (size_t)HALF * ldb * 2, khoff = (size_t)K * 2;
    const size_t tstepA = 2 * hstepA, tstepB = 2 * hstepB;
    const unsigned ldsw = (unsigned)wid * 1024u;
    const int aoff = lds_byte(wr * 64 + fr, fq * 8), boff = lds_byte(wc * 32 + fr, fq * 8);
#define PG8_SA(b, h) (((b) * 2 + (h)) * HTB)
#define PG8_SB(b, h) ((4 + (b) * 2 + (h)) * HTB)
#define PG8_STAGE(bufoff, gbase, voff) do { _Pragma("unroll") for (int _i = 0; _i < 2; ++_i) \
        __builtin_amdgcn_global_load_lds((const unsigned*)((const char*)(gbase) + (voff)[_i]), (PG8_LAS unsigned*)(lds + (bufoff) + ldsw + _i * 8192), 16, 0, 0); } while (0)
#define PG8_LDA(dst, b, h) do { _Pragma("unroll") for (int m = 0; m < 4; ++m) _Pragma("unroll") for (int k = 0; k < 2; ++k) dst[m][k] = *(const PG8_LAS bf16x8*)(lds + PG8_SA(b, h) + aoff + m * 2048 + k * 1024); } while (0)
#define PG8_LDB(dst, b, h) do { _Pragma("unroll") for (int n = 0; n < 2; ++n) _Pragma("unroll") for (int k = 0; k < 2; ++k) dst[n][k] = *(const PG8_LAS bf16x8*)(lds + PG8_SB(b, h) + boff + n * 2048 + k * 1024); } while (0)
#define PG8_MMA(ai, bj, At, Bt) do { __builtin_amdgcn_s_setprio(1); _Pragma("unroll") for (int m = 0; m < 4; ++m) _Pragma("unroll") for (int n = 0; n < 2; ++n) _Pragma("unroll") for (int k = 0; k < 2; ++k) \
        acc[ai][bj][m][n] = __builtin_amdgcn_mfma_f32_16x16x32_bf16(Bt[n][k], At[m][k], acc[ai][bj][m][n], 0, 0, 0); __builtin_amdgcn_s_setprio(0); } while (0)
#define PG8_WAIT_V(n) asm volatile("s_waitcnt vmcnt(" #n ")" ::: "memory")
#define PG8_WAIT_L(n) asm volatile("s_waitcnt lgkmcnt(" #n ")" ::: "memory")
#define PG8_BAR __builtin_amdgcn_s_barrier()
#define PG8_SCHED __builtin_amdgcn_sched_barrier(0)
    Unit cur, nxt; int ui = 0;
    if (!S.next(0, cur)) return;
    f32x4 acc[2][2][4][2];
#pragma unroll
    for (int a = 0; a < 2; ++a)
#pragma unroll
        for (int b = 0; b < 2; ++b)
#pragma unroll
            for (int m = 0; m < 4; ++m)
#pragma unroll
                for (int n = 0; n < 2; ++n) acc[a][b][m][n] = (f32x4){0.f, 0.f, 0.f, 0.f};
    bf16x8 At[4][2], B0[2][2], B1[2][2];
    const char* cA = (const char*)g.A + (size_t)cur.pm * tstepA + (size_t)cur.kh * khoff; const char* cB = (const char*)g.Bt + (size_t)cur.pn * tstepB + (size_t)cur.kh * khoff;
    S.a_ready(cur);
    if constexpr (SP2) {
        PG8_STAGE(PG8_SB(0, 0), cB, voffB); PG8_STAGE(PG8_SB(0, 1), cB + hstepB, voffB); PG8_STAGE(PG8_SA(0, 0), cA, voffA); PG8_STAGE(PG8_SA(0, 1), cA + hstepA, voffA);
        if (wr == 1) PG8_BAR;
        PG8_WAIT_V(2); PG8_BAR;
        PG8_STAGE(PG8_SB(1, 0), cB + kstep, voffB); PG8_STAGE(PG8_SA(1, 0), cA + kstep, voffA); PG8_STAGE(PG8_SB(1, 1), cB + hstepB + kstep, voffB);
        PG8_WAIT_V(6); PG8_BAR;
    } else {
        PG8_STAGE(PG8_SB(0, 0), cB, voffB); PG8_STAGE(PG8_SA(0, 0), cA, voffA); PG8_STAGE(PG8_SB(0, 1), cB + hstepB, voffB); PG8_STAGE(PG8_SA(0, 1), cA + hstepA, voffA);
        if (wr == 1) PG8_BAR;
        PG8_WAIT_V(4); PG8_BAR;
        PG8_STAGE(PG8_SB(1, 0), cB + kstep, voffB); PG8_STAGE(PG8_SA(1, 0), cA + kstep, voffA); PG8_STAGE(PG8_SB(1, 1), cB + hstepB + kstep, voffB);
        PG8_WAIT_V(6); PG8_BAR;
    }
    for (;;) {
        const bool has_next = S.next(ui + 1, nxt);
        const char* nA = has_next ? (const char*)g.A + (size_t)nxt.pm * tstepA + (size_t)nxt.kh * khoff : cA; const char* nB = has_next ? (const char*)g.Bt + (size_t)nxt.pn * tstepB + (size_t)nxt.kh * khoff : cB;
        for (int t = 0; t < nt; t += 2) {
            const bool last = (t == nt - 2);
            const char* a1 = cA + (size_t)(t + 1) * kstep;
            const char* a2 = last ? nA : cA + (size_t)(t + 2) * kstep; const char* b2 = last ? nB : cB + (size_t)(t + 2) * kstep;
            const char* a3 = a2 + kstep; const char* b3 = b2 + kstep;
            if (last && has_next) S.a_ready(nxt);
            if constexpr (SP2) {
            PG8_LDB(B0, 0, 0); PG8_LDB(B1, 0, 1); PG8_SCHED; PG8_LDA(At, 0, 0); PG8_STAGE(PG8_SA(1, 1), a1 + hstepA, voffA);
            PG8_WAIT_V(8); PG8_WAIT_L(0); PG8_BAR; PG8_MMA(0, 0, At, B0); PG8_MMA(0, 1, At, B1); PG8_BAR; PG8_SCHED;
            PG8_LDA(At, 0, 1); PG8_STAGE(PG8_SB(0, 0), b2, voffB); PG8_STAGE(PG8_SB(0, 1), b2 + hstepB, voffB); PG8_STAGE(PG8_SA(0, 0), a2, voffA);
            PG8_WAIT_V(8); PG8_WAIT_L(0); PG8_BAR; PG8_MMA(1, 0, At, B0); PG8_MMA(1, 1, At, B1); PG8_BAR; PG8_SCHED;
            PG8_LDB(B0, 1, 0); PG8_LDB(B1, 1, 1); PG8_SCHED; PG8_LDA(At, 1, 0); PG8_STAGE(PG8_SA(0, 1), a2 + hstepA, voffA);
            PG8_WAIT_V(8); PG8_WAIT_L(0); PG8_BAR; PG8_MMA(0, 0, At, B0); PG8_MMA(0, 1, At, B1); PG8_BAR; PG8_SCHED;
            PG8_LDA(At, 1, 1); PG8_STAGE(PG8_SB(1, 0), b3, voffB); PG8_STAGE(PG8_SB(1, 1), b3 + hstepB, voffB); PG8_STAGE(PG8_SA(1, 0), a3, voffA);
            PG8_WAIT_V(8); PG8_WAIT_L(0); PG8_BAR; PG8_MMA(1, 0, At, B0); PG8_MMA(1, 1, At, B1); PG8_BAR; PG8_SCHED;
            } else {
            PG8_LDB(B0, 0, 0); PG8_SCHED; PG8_LDA(At, 0, 0); PG8_STAGE(PG8_SA(1, 1), a1 + hstepA, voffA);
            PG8_WAIT_L(8); PG8_BAR; PG8_WAIT_L(0); PG8_MMA(0, 0, At, B0); PG8_BAR; PG8_SCHED;
            PG8_LDB(B1, 0, 1); PG8_STAGE(PG8_SB(0, 0), b2, voffB);
            PG8_BAR; PG8_WAIT_L(0); PG8_MMA(0, 1, At, B1); PG8_BAR;
            PG8_LDA(At, 0, 1); PG8_STAGE(PG8_SA(0, 0), a2, voffA);
            PG8_BAR; PG8_WAIT_L(0); PG8_MMA(1, 0, At, B0); PG8_BAR; PG8_SCHED;
            PG8_STAGE(PG8_SB(0, 1), b2 + hstepB, voffB);
            PG8_WAIT_V(6); PG8_BAR; PG8_MMA(1, 1, At, B1); PG8_BAR;
            PG8_LDB(B0, 1, 0); PG8_SCHED; PG8_LDA(At, 1, 0); PG8_STAGE(PG8_SA(0, 1), a2 + hstepA, voffA);
            PG8_WAIT_L(8); PG8_BAR; PG8_WAIT_L(0); PG8_MMA(0, 0, At, B0); PG8_BAR; PG8_SCHED;
            PG8_LDB(B1, 1, 1); PG8_STAGE(PG8_SB(1, 0), b3, voffB);
            PG8_BAR; PG8_WAIT_L(0); PG8_MMA(0, 1, At, B1); PG8_BAR;
            PG8_LDA(At, 1, 1); PG8_STAGE(PG8_SA(1, 0), a3, voffA);
            PG8_BAR; PG8_WAIT_L(0); PG8_MMA(1, 0, At, B0); PG8_BAR; PG8_SCHED;
            PG8_STAGE(PG8_SB(1, 1), b3 + hstepB, voffB);
            PG8_WAIT_V(6); PG8_BAR; PG8_MMA(1, 1, At, B1); PG8_BAR;
            }
        }
        if constexpr (ALIGN_EPI) { if (wr == 0) PG8_BAR; }
        bool keep_acc = false;
        if constexpr (Epi::SPLIT2) keep_acc = (cur.kh == 0);
        if constexpr (!Epi::AFTER_DRAIN) { if constexpr (Epi::SPLIT2) { if (keep_acc) E.mid(acc, cur, wr, wc, fr, fq); else E(acc, cur, wr, wc, fr, fq); } else E(acc, cur, wr, wc, fr, fq); S.done(cur); }
        if (!has_next) break;
        if (!keep_acc)
#pragma unroll
        for (int a = 0; a < 2; ++a)
#pragma unroll
            for (int b = 0; b < 2; ++b)
#pragma unroll
                for (int m = 0; m < 4; ++m)
#pragma unroll
                    for (int n = 0; n < 2; ++n) acc[a][b][m][n] = (f32x4){0.f, 0.f, 0.f, 0.f};
        cur = nxt; cA = nA; cB = nB; ++ui;
        if constexpr (ALIGN_EPI) { if (wr == 1) PG8_BAR; }
    }
    PG8_WAIT_V(0);
    if constexpr (!ALIGN_EPI) { if (wr == 0) PG8_BAR; }
    PG8_BAR;
    if constexpr (Epi::AFTER_DRAIN) { E.fused(acc, cur, wr, wc, fr, fq, lds, wid, lane); S.done(cur); }
#undef PG8_SA
#undef PG8_SB
#undef PG8_STAGE
#undef PG8_LDA
#undef PG8_LDB
#undef PG8_MMA
#undef PG8_WAIT_V
#undef PG8_WAIT_L
#undef PG8_BAR
#undef PG8_SCHED
}
}

using pg8::bf16_t; using pg8::bf16x8; using pg8::f32x4; using pg8::u32x4; using pg8::Unit; using pg8::cvt_pk_bf16;
typedef unsigned u32x2 __attribute__((ext_vector_type(2)));
#define LAS __attribute__((address_space(3)))

constexpr int MP = 32768, MS = 128, MTOT = MP + MS, MPAD = 33024;
constexpr int DM = 1024, NIN = 3840, DFF = 3072, NUP = 6144;
constexpr float EPSN = 1e-6f;
constexpr float LOG2E = 1.4426950408889634f;
constexpr float QSCALE = 0.125f * LOG2E;
constexpr size_t O_Y = 0, O_KP = 33685504, O_VP = 33947648, O_GP = 34209792, O_CP = 35258368, O_KS = 35454976, O_VS = 37552128, O_GS = 39649280, O_CS = 39714816, O_END = 41287680;
constexpr size_t MiB = 1u << 20;
constexpr size_t WS_WIN = 1 * MiB, WS_WPA = 9 * MiB, WS_WPB = 10 * MiB, WS_WO = 11 * MiB, WS_WUP = 13 * MiB, WS_WDN = 25 * MiB, WS_WSB = 31 * MiB, WS_ROPE = 31 * MiB + 512 * 1024;
constexpr size_t WS_SSQ1 = 32 * MiB, WS_SSQ2 = 35 * MiB;
constexpr size_t WS_XN = 40 * MiB, WS_U = 105 * MiB, WS_AV = 138 * MiB, WS_Q = 171 * MiB, WS_KB = 204 * MiB, WS_VB = 213 * MiB, WS_SA = 222 * MiB, WS_SB = 287 * MiB;
constexpr size_t WS_Y = 352 * MiB, WS_T = 418 * MiB, WS_MG = 105 * MiB, WS_X2B = 105 * MiB, WS_X1B = 40 * MiB, WS_ACT = 222 * MiB, WS_HEAD = 418 * MiB, WS_TAIL = 443 * MiB, WS_END = 483 * MiB;
constexpr int LDS_BYTES = 147456;

struct Args { const float* in[21]; float* out; unsigned char* ws; int dbg; int pad; };

__device__ __forceinline__ float bflo(unsigned w) { return __uint_as_float(w << 16); }
__device__ __forceinline__ float bfhi(unsigned w) { return __uint_as_float(w & 0xffff0000u); }
__device__ __forceinline__ float bf2f(bf16_t h) { return __uint_as_float((unsigned)h << 16); }
__device__ __forceinline__ bf16_t f2bf(float f) { return (bf16_t)(cvt_pk_bf16(f, 0.f) & 0xffffu); }
__device__ __forceinline__ float gelu_t(float x) { const float u = x * (1.5957691216f + 0.0713548163f * x * x); const float e = __builtin_amdgcn_exp2f(-LOG2E * u); return x * __builtin_amdgcn_rcpf(1.f + e); }
__device__ __forceinline__ float sigm(float x) { return __builtin_amdgcn_rcpf(1.f + __builtin_amdgcn_exp2f(-LOG2E * x)); }
__device__ __forceinline__ u32x2 pack4(f32x4 v) { u32x2 w; w.x = cvt_pk_bf16(v[0], v[1]); w.y = cvt_pk_bf16(v[2], v[3]); return w; }
__device__ __forceinline__ f32x4 unpack4(u32x2 w) { return (f32x4){bflo(w.x), bfhi(w.x), bflo(w.y), bfhi(w.y)}; }
__device__ __forceinline__ float wave_sum(float v) {
#pragma unroll
    for (int o = 1; o < 64; o <<= 1) v += __shfl_xor(v, o);
    return v;
}
__device__ __forceinline__ float wave_max(float v) {
#pragma unroll
    for (int o = 1; o < 64; o <<= 1) v = fmaxf(v, __shfl_xor(v, o));
    return v;
}

typedef const f32x4 (&AccRef)[2][2][4][2];

struct EpiIn {
    static constexpr bool PERM = false, AFTER_DRAIN = false; static constexpr bool SPLIT2 = false;
    bf16_t *U, *AV, *Q, *KB, *VB, *SA, *SB; const float* rope; float* out;
    __device__ __forceinline__ void operator()(AccRef acc, const Unit& u, int wr, int wc, int fr, int fq) const {
        const int pn = u.pn;
        const int rbase = u.pm * 256 + wr * 64 + fr;
        const int cl = wc * 32 + 4 * fq;
        if (pn < 4) {
            bf16_t* base = pn < 2 ? U : AV; const int c0 = (pn & 1) * 256;
#pragma unroll
            for (int ai = 0; ai < 2; ++ai)
#pragma unroll
                for (int m = 0; m < 4; ++m) {
                    const int row = rbase + ai * 128 + m * 16;
                    if (row < MTOT) {
                        bf16_t* rp = base + (size_t)row * 512 + c0 + wc * 32 + 8 * fq;
#pragma unroll
                        for (int bj = 0; bj < 2; ++bj) {
                            f32x4 v0 = acc[ai][bj][m][0], v1 = acc[ai][bj][m][1];
                            v0[0] = gelu_t(v0[0]); v0[1] = gelu_t(v0[1]); v0[2] = gelu_t(v0[2]); v0[3] = gelu_t(v0[3]);
                            v1[0] = gelu_t(v1[0]); v1[1] = gelu_t(v1[1]); v1[2] = gelu_t(v1[2]); v1[3] = gelu_t(v1[3]);
                            const u32x2 lo = pack4(v0), hi = pack4(v1);
                            *(u32x4*)(rp + bj * 128) = (u32x4){lo.x, lo.y, hi.x, hi.y};
                        }
                    }
                }
        } else if (pn >= 7) {
            const int c0 = (pn - 7) * 128 + wc * 32 + 8 * fq;
#pragma unroll
            for (int ai = 0; ai < 2; ++ai)
#pragma unroll
                for (int m = 0; m < 4; ++m) {
                    const int row = rbase + ai * 128 + m * 16;
                    if (row < MTOT) {
                        u32x2 rw[2], sw[2];
#pragma unroll
                        for (int n = 0; n < 2; ++n) {
                            const f32x4 ga = acc[ai][0][m][n], gb = acc[ai][1][m][n];
                            f32x4 r, sb;
#pragma unroll
                            for (int j = 0; j < 4; ++j) {
                                const float ea = __builtin_amdgcn_exp2f(-LOG2E * ga[j]), eb = __builtin_amdgcn_exp2f(-LOG2E * gb[j]);
                                sb[j] = __builtin_amdgcn_rcpf(1.f + eb); r[j] = (1.f + eb) * __builtin_amdgcn_rcpf(1.f + ea);
                            }
                            rw[n] = pack4(r); sw[n] = pack4(sb);
                        }
                        const size_t off = (size_t)row * 1024 + c0;
                        *(u32x4*)(SA + off) = (u32x4){rw[0].x, rw[0].y, rw[1].x, rw[1].y}; *(u32x4*)(SB + off) = (u32x4){sw[0].x, sw[0].y, sw[1].x, sw[1].y};
                    }
                }
        } else {
            const int g = wc & 1, i0 = g * 16 + 4 * fq;
#pragma unroll
            for (int ai = 0; ai < 2; ++ai) {
                f32x4 rc0[4], rc1[4];
#pragma unroll
                for (int m = 0; m < 4; ++m) { const int row_ = rbase + ai * 128 + m * 16; const int pidx_ = row_ >= MP ? 2048 : (row_ & 2047);
                    const f32x4* rp_ = (const f32x4*)(rope + ((size_t)pidx_ * 32 + i0) * 2); rc0[m] = rp_[0]; rc1[m] = rp_[1]; }
#pragma unroll
                for (int m = 0; m < 4; ++m) {
                    const int row = rbase + ai * 128 + m * 16;
                    if (row < MTOT) {
                        const bool smp = row >= MP;
                        const f32x4 cs0 = rc0[m], cs1 = rc1[m];
                        const f32x4 cc = (f32x4){cs0[0], cs0[2], cs1[0], cs1[2]}, ss = (f32x4){cs0[1], cs0[3], cs1[1], cs1[3]};
                        const int s = row & 2047, bb = row >> 11;
#pragma unroll
                        for (int bj = 0; bj < 2; ++bj) {
                            if (pn == 6 && bj == 1) {
#pragma unroll
                                for (int n = 0; n < 2; ++n) {
                                    const int col = wc * 32 + 8 * fq + 4 * n;
                                    const f32x4 v = acc[ai][1][m][n];
                                    *(u32x2*)(VB + (size_t)row * 128 + col) = pack4(v);
                                    if (smp) *(f32x4*)(out + O_VS + ((size_t)(row - MP) * 128 + 127) * 128 + col) = v;
                                    else if (s >= 1920) *(f32x4*)(out + O_VP + ((size_t)bb * 128 + (s - 1920)) * 128 + col) = v;
                                }
                            } else {
                                const f32x4 x1 = acc[ai][bj][m][0], x2 = acc[ai][bj][m][1];
                                f32x4 o1 = x1 * cc - x2 * ss, o2 = x2 * cc + x1 * ss;
                                if (pn < 6) {
                                    const int ht = 2 * bj + (wc >> 1);
                                    o1 = o1 * QSCALE; o2 = o2 * QSCALE;
                                    bf16_t* qp = Q + (size_t)row * 512 + (pn - 4) * 256 + ht * 64 + i0;
                                    *(u32x2*)qp = pack4(o1); *(u32x2*)(qp + 32) = pack4(o2);
                                } else {
                                    const int hd = wc >> 1;
                                    bf16_t* kp = KB + (size_t)row * 128 + hd * 64 + i0;
                                    *(u32x2*)kp = pack4(o1); *(u32x2*)(kp + 32) = pack4(o2);
                                    if (smp) { float* op = out + O_KS + ((size_t)(row - MP) * 128 + 127) * 128 + hd * 64 + i0; *(f32x4*)op = o1; *(f32x4*)(op + 32) = o2; }
                                    else if (s >= 1920) { float* op = out + O_KP + ((size_t)bb * 128 + (s - 1920)) * 128 + hd * 64 + i0; *(f32x4*)op = o1; *(f32x4*)(op + 32) = o2; }
                                }
                            }
                        }
                    }
                }
            }
        }
    }
};

struct EpiGate {
    static constexpr bool PERM = true, AFTER_DRAIN = false; static constexpr bool SPLIT2 = true;
    const bf16_t* SA; const bf16_t* SB; bf16_t* MG;
    __device__ __forceinline__ void mid(f32x4 (&acc)[2][2][4][2], const Unit& u, int wr, int wc, int fr, int fq) const {
        const int rbase = u.pm * 256 + wr * 64 + fr, c0 = u.pn * 256 + wc * 32 + 8 * fq;
#pragma unroll
        for (int ai = 0; ai < 2; ++ai)
#pragma unroll
            for (int m = 0; m < 4; ++m) {
                const int row = rbase + ai * 128 + m * 16;
#pragma unroll
                for (int bj = 0; bj < 2; ++bj) {
                    const u32x4 w = *(const u32x4*)(SA + (size_t)row * 1024 + c0 + bj * 128);
                    acc[ai][bj][m][0] = acc[ai][bj][m][0] * unpack4((u32x2){w.x, w.y});
                    acc[ai][bj][m][1] = acc[ai][bj][m][1] * unpack4((u32x2){w.z, w.w});
                }
            }
    }
    __device__ __forceinline__ void operator()(AccRef acc, const Unit& u, int wr, int wc, int fr, int fq) const {
        const int rbase = u.pm * 256 + wr * 64 + fr, c0 = u.pn * 256 + wc * 32 + 8 * fq;
#pragma unroll
        for (int ai = 0; ai < 2; ++ai) {
            u32x4 sbw[4][2];
#pragma unroll
            for (int m = 0; m < 4; ++m)
#pragma unroll
                for (int bj = 0; bj < 2; ++bj) sbw[m][bj] = *(const u32x4*)(SB + (size_t)(rbase + ai * 128 + m * 16) * 1024 + c0 + bj * 128);
#pragma unroll
            for (int m = 0; m < 4; ++m) {
                const int row = rbase + ai * 128 + m * 16;
#pragma unroll
                for (int bj = 0; bj < 2; ++bj) {
                    const u32x2 lo = pack4(unpack4((u32x2){sbw[m][bj].x, sbw[m][bj].y}) * acc[ai][bj][m][0]), hi = pack4(unpack4((u32x2){sbw[m][bj].z, sbw[m][bj].w}) * acc[ai][bj][m][1]);
                    *(u32x4*)(MG + (size_t)row * 1024 + c0 + bj * 128) = (u32x4){lo.x, lo.y, hi.x, hi.y};
                }
            }
        }
    }
};
struct EpiRes {
    static constexpr bool PERM = true, AFTER_DRAIN = false; static constexpr bool SPLIT2 = false;
    const float* xp; const bf16_t* xbin; bf16_t* XB; float* ssq;
    __device__ __forceinline__ void operator()(AccRef acc, const Unit& u, int wr, int wc, int fr, int fq) const {
        const int rbase = u.pm * 256 + wr * 64 + fr, c0 = u.pn * 256 + wc * 32 + 8 * fq;
#pragma unroll
        for (int ai = 0; ai < 2; ++ai) {
            f32x4 bs[4][2][2];
            if (xbin) {
#pragma unroll
                for (int m = 0; m < 4; ++m)
#pragma unroll
                    for (int bj = 0; bj < 2; ++bj) { const u32x4 w = *(const u32x4*)(xbin + (size_t)(rbase + ai * 128 + m * 16) * 1024 + c0 + bj * 128);
                        bs[m][bj][0] = unpack4((u32x2){w.x, w.y}); bs[m][bj][1] = unpack4((u32x2){w.z, w.w}); }
            } else {
#pragma unroll
                for (int m = 0; m < 4; ++m)
#pragma unroll
                    for (int bj = 0; bj < 2; ++bj)
#pragma unroll
                        for (int n = 0; n < 2; ++n) bs[m][bj][n] = __builtin_nontemporal_load((const f32x4*)(xp + (size_t)(rbase + ai * 128 + m * 16) * 1024 + c0 + bj * 128 + n * 4));
            }
#pragma unroll
            for (int m = 0; m < 4; ++m) {
                const int row = rbase + ai * 128 + m * 16;
                float q = 0.f;
#pragma unroll
                for (int bj = 0; bj < 2; ++bj) {
                    const f32x4 v0 = bs[m][bj][0] + acc[ai][bj][m][0], v1 = bs[m][bj][1] + acc[ai][bj][m][1];
                    const u32x2 lo = pack4(v0), hi = pack4(v1);
                    *(u32x4*)(XB + (size_t)row * 1024 + c0 + bj * 128) = (u32x4){lo.x, lo.y, hi.x, hi.y};
                    q += ((v0[0] * v0[0] + v0[1] * v0[1]) + (v0[2] * v0[2] + v0[3] * v0[3])) + ((v1[0] * v1[0] + v1[1] * v1[1]) + (v1[2] * v1[2] + v1[3] * v1[3]));
                }
                q += __shfl_xor(q, 16); q += __shfl_xor(q, 32);
                if (fq == 0) ssq[(size_t)row * 16 + u.pn * 4 + wc] = q;
            }
        }
    }
};
#ifndef USE_DPP
#define USE_DPP 1
#endif
__device__ __forceinline__ float rot_prev(float x, int srcl, int ctrl_is_2) {
#if USE_DPP
    return ctrl_is_2 ? __uint_as_float(__builtin_amdgcn_update_dpp(0, __float_as_uint(x), 0x122, 0xf, 0xf, false)) : __uint_as_float(__builtin_amdgcn_update_dpp(0, __float_as_uint(x), 0x121, 0xf, 0xf, false));
#else
    return __shfl(x, srcl, 16);
#endif
}
struct EpiUp {
    static constexpr bool PERM = false, AFTER_DRAIN = false; static constexpr bool SPLIT2 = false;
    const float* ssq1; const float* cw; const float* cb; bf16_t* ACT; float* HEAD; float* TAIL; float* out; LAS float* wlds;
    __device__ __forceinline__ void operator()(AccRef acc, const Unit& u, int wr, int wc, int fr, int fq) const {
        const int pn = u.pn, pm = u.pm;
        const int colA = pn * 128 + wc * 32 + 4 * fq;
        const int lane15m1 = (fr + 15) & 15, lane15m2 = (fr + 14) & 15;
        LAS float* wl = wlds + (wr * 4 + wc) * 256;
        float rstdv[2][4];
        {
            f32x4 sv[2][4];
#pragma unroll
            for (int ai = 0; ai < 2; ++ai)
#pragma unroll
                for (int m = 0; m < 4; ++m) sv[ai][m] = *(const f32x4*)(ssq1 + (size_t)(pm * 256 + ai * 128 + wr * 64 + m * 16 + fr) * 16 + 4 * fq);
#pragma unroll
            for (int ai = 0; ai < 2; ++ai)
#pragma unroll
                for (int m = 0; m < 4; ++m) { float sq = (sv[ai][m][0] + sv[ai][m][1]) + (sv[ai][m][2] + sv[ai][m][3]); sq += __shfl_xor(sq, 16); sq += __shfl_xor(sq, 32); rstdv[ai][m] = rsqrtf(sq * (1.f / 1024.f) + EPSN); }
        }
        {
            const int g = fq * 16 + fr, kind = g >> 4, bjj = (g >> 3) & 1, c4 = (g & 7) * 4;
            const float* src = (kind < 3 ? cw + kind * 6144 : cb) + bjj * 3072 + pn * 128 + wc * 32 + c4;
            *(LAS f32x4*)(wl + g * 4) = *(const f32x4*)src;
        }
#pragma unroll
        for (int ai = 0; ai < 2; ++ai) {
            const int rowb = pm * 256 + ai * 128 + wr * 64;
            const int blk = rowb >> 6;
            f32x4 pv[2][2];
#pragma unroll
            for (int bj = 0; bj < 2; ++bj)
#pragma unroll
                for (int n = 0; n < 2; ++n) pv[bj][n] = (f32x4){0.f, 0.f, 0.f, 0.f};
#pragma unroll
            for (int m = 0; m < 4; ++m) {
                const int row = rowb + m * 16 + fr;
                const float rstd = rstdv[ai][m];
                const int s = row & 2047;
#pragma unroll
                for (int n = 0; n < 2; ++n) {
                    f32x4 cc[2];
#pragma unroll
                    for (int bj = 0; bj < 2; ++bj) {
                        const int ac = bj * 3072 + colA + 16 * n;
                        const f32x4 v = acc[ai][bj][m][n] * rstd;
                        if (m == 0 && fr < 2) *(f32x4*)(HEAD + ((size_t)blk * 2 + fr) * 6144 + ac) = v;
                        if (m == 3 && fr >= 14) *(f32x4*)(TAIL + ((size_t)blk * 2 + (fr - 14)) * 6144 + ac) = v;
                        if (m == 3 && ai == 1 && wr == 1 && (pm & 7) == 7 && s >= 2046) *(f32x4*)(out + O_CP + ((size_t)(row >> 11) * 2 + (s - 2046)) * 6144 + ac) = v;
                        const LAS float* wp = wl + bj * 32 + 16 * n + 4 * fq;
                        const f32x4 w0 = *(const LAS f32x4*)(wp), w1 = *(const LAS f32x4*)(wp + 64), w2 = *(const LAS f32x4*)(wp + 128), b0 = *(const LAS f32x4*)(wp + 192);
                        f32x4 v1, v2;
#pragma unroll
                        for (int j = 0; j < 4; ++j) {
                            const float cur = v[j], prv = pv[bj][n][j];
                            const float sel1 = (fr == 15) ? prv : cur, sel2 = (fr >= 14) ? prv : cur;
                            v1[j] = rot_prev(sel1, lane15m1, 0); v2[j] = rot_prev(sel2, lane15m2, 1);
                        }
                        cc[bj] = b0 + w0 * v2 + w1 * v1 + w2 * v;
                        pv[bj][n] = v;
                    }
                    f32x4 a;
#pragma unroll
                    for (int j = 0; j < 4; ++j) a[j] = gelu_t(cc[0][j]) * cc[1][j];
                    if (m > 0 || fr >= 2) *(u32x2*)(ACT + (size_t)row * 3072 + colA + 16 * n) = pack4(a);
                }
            }
        }
    }
};

__device__ __forceinline__ unsigned f2bf_sw(float f) { unsigned u = __float_as_uint(f); return (u + 0x7fffu + ((u >> 16) & 1u)) >> 16; }
__device__ __forceinline__ unsigned pk2(float lo, float hi) { return f2bf_sw(lo) | (f2bf_sw(hi) << 16); }
__device__ __forceinline__ int perm32c(int w) { return 8 * ((w >> 2) & 3) + 4 * (w >> 4) + (w & 3); }
__device__ __forceinline__ int map_in(int p) {
    if (p >= 1792) { const int t = (p - 1792) >> 8, q = (p - 1792) & 255; return 1792 + (q >> 7) * 1024 + t * 128 + (q & 96) + perm32c(q & 31); }
    if (p < 1024 || p >= 1664) return (p & ~31) + perm32c(p & 31);
    const int h64 = p & ~63, g = (p & 63) >> 5, w = p & 31;
    return h64 + (w >> 4) * 32 + g * 16 + (w & 15);
}
__device__ __forceinline__ int map_up(int p) { const int pn = p >> 8, q = p & 255; return (q >> 7) * 3072 + pn * 128 + (q & 127); }
template <int MAPID>
__device__ __forceinline__ void p0_transpose_item(const float* W, int K, int N, bf16_t* WT, const float* kscale, LAS float* scr, int item, int lane, int ldk = 0, int koff = 0) {
    if (ldk == 0) ldk = K;
    const int nblk = N / 32, kb = item / nblk, nb = item % nblk, k0 = 64 * kb, n0 = 32 * nb;
    const int p = n0 + (lane & 31);
    const int src = MAPID == 1 ? map_in(p) : (MAPID == 2 ? map_up(p) : p);
    float wv[32];
#pragma unroll
    for (int i = 0; i < 32; ++i) { const int kk = 2 * i + (lane >> 5); wv[i] = W[(size_t)(k0 + kk) * N + src]; }
    if (kscale) {
#pragma unroll
        for (int i = 0; i < 32; ++i) wv[i] *= kscale[k0 + 2 * i + (lane >> 5)];
    }
#pragma unroll
    for (int i = 0; i < 32; ++i) scr[(2 * i + (lane >> 5)) * 33 + (lane & 31)] = wv[i];
    asm volatile("s_waitcnt lgkmcnt(0)" ::: "memory");
    const int c = lane & 7;
#pragma unroll
    for (int j = 0; j < 4; ++j) { const int n = (lane >> 3) + 8 * j; const LAS float* s = scr + (8 * c) * 33 + n;
        u32x4 o; o.x = pk2(s[0 * 33], s[1 * 33]); o.y = pk2(s[2 * 33], s[3 * 33]); o.z = pk2(s[4 * 33], s[5 * 33]); o.w = pk2(s[6 * 33], s[7 * 33]);
        *(u32x4*)(WT + (size_t)(n0 + n) * ldk + koff + k0 + 8 * c) = o; }
    asm volatile("s_waitcnt lgkmcnt(0)" ::: "memory");
}

__device__ __forceinline__ void p0_prologue(const Args& a, LAS unsigned char* lds, int part, int wk, int nwk) {
    const int tid = threadIdx.x, lane = tid & 63, wave = __builtin_amdgcn_readfirstlane(tid >> 6);
    unsigned char* ws = a.ws;
    LAS float* scr = (LAS float*)(lds + wave * 16384);
    const int gw = wk * 8 + wave, NGW = nwk * 8;
    const long gt = (long)wk * 512 + tid, NT = (long)nwk * 512;
    constexpr int I_IN = 16 * 120, I_PA = 8 * 32, I_PB = 8 * 32, I_O = 16 * 32, I_UP = 16 * 192, I_DN = 48 * 32;
    constexpr int NITEMS = I_IN + I_PA + I_PB + I_O + I_UP + I_DN;
    if (part == 1)
    for (int it = I_IN + gw; it < NITEMS; it += NGW) {
        int r = it;
        if (r < I_IN) { p0_transpose_item<1>(a.in[6], 1024, NIN, (bf16_t*)(ws + WS_WIN), nullptr, scr, r, lane); continue; } r -= I_IN;
        if (r < I_PA) { p0_transpose_item<0>(a.in[12], 512, 1024, (bf16_t*)(ws + WS_WPA), nullptr, scr, r, lane, 1024, 0); continue; } r -= I_PA;
        if (r < I_PB) { p0_transpose_item<0>(a.in[13], 512, 1024, (bf16_t*)(ws + WS_WPA), nullptr, scr, r, lane, 1024, 512); continue; } r -= I_PB;
        if (r < I_O) { p0_transpose_item<0>(a.in[14], 1024, 1024, (bf16_t*)(ws + WS_WO), nullptr, scr, r, lane); continue; } r -= I_O;
        if (r < I_UP) { p0_transpose_item<2>(a.in[16], 1024, NUP, (bf16_t*)(ws + WS_WUP), a.in[15], scr, r, lane); continue; } r -= I_UP;
        p0_transpose_item<0>(a.in[19], 3072, 1024, (bf16_t*)(ws + WS_WDN), nullptr, scr, r, lane);
    }
    if (part == 0) {
        bf16_t* XN = (bf16_t*)(ws + WS_XN); const float* g = a.in[5];
        f32x4 gg[4];
#pragma unroll
        for (int j = 0; j < 4; ++j) gg[j] = ((const f32x4*)g)[64 * j + lane];
        for (int ch = gw; ch < MPAD / 8; ch += NGW) {
            const int rowc = ch * 8;
            if (rowc >= MTOT) {
#pragma unroll
                for (int r = 0; r < 8; ++r) { unsigned long long* o8 = (unsigned long long*)(XN + (size_t)(rowc + r) * 1024) + lane;
#pragma unroll
                    for (int j = 0; j < 4; ++j) o8[64 * j] = 0ull; }
                continue;
            }
            const float* xr = rowc < MP ? a.in[0] + (size_t)rowc * 1024 : a.in[1] + (size_t)(rowc - MP) * 1024;
            f32x4 v[8][4];
#pragma unroll
            for (int r = 0; r < 8; ++r)
#pragma unroll
                for (int j = 0; j < 4; ++j) v[r][j] = __builtin_nontemporal_load(((const f32x4*)(xr + (size_t)r * 1024)) + 64 * j + lane);
#pragma unroll
            for (int r = 0; r < 8; ++r) {
                float s = 0.f;
#pragma unroll
                for (int j = 0; j < 4; ++j) s += (v[r][j][0] * v[r][j][0] + v[r][j][1] * v[r][j][1]) + (v[r][j][2] * v[r][j][2] + v[r][j][3] * v[r][j][3]);
                const float rstd = rsqrtf(wave_sum(s) * (1.f / 1024.f) + EPSN);
                unsigned long long* o8 = (unsigned long long*)(XN + (size_t)(rowc + r) * 1024) + lane;
#pragma unroll
                for (int j = 0; j < 4; ++j) { const f32x4 y = v[r][j] * rstd * gg[j];
                    o8[64 * j] = (unsigned long long)cvt_pk_bf16(y[0], y[1]) | ((unsigned long long)cvt_pk_bf16(y[2], y[3]) << 32); }
            }
        }
    }
    if (part == 0)
    for (int it = gw; it < I_IN; it += NGW) p0_transpose_item<1>(a.in[6], 1024, NIN, (bf16_t*)(ws + WS_WIN), nullptr, scr, it, lane);
    if (part == 0) {
        float* rope = (float*)(ws + WS_ROPE);
        for (long e = gt; e < 2049 * 32; e += NT) {
            const int pi = (int)(e >> 5), i = (int)(e & 31);
            const double pos = pi == 2048 ? 16384.0 : (double)pi;
            double inv = 1.0; for (int k = 0; k < i; ++k) inv *= 0.74989420933245582730;
            double turns = pos * inv * 0.15915494309189533577;
            turns -= __builtin_floor(turns);
            const float tf = (float)turns;
            rope[e * 2] = __builtin_amdgcn_cosf(tf); rope[e * 2 + 1] = __builtin_amdgcn_sinf(tf);
        }
    }
    if (part == 1) {
        bf16_t* WSB = (bf16_t*)(ws + WS_WSB); const float* w_s = a.in[9];
        for (long e = gt; e < 8 * 128 * 128; e += NT) { const int t = (int)(e >> 7) & 127, s = (int)e & 127; WSB[e] = (s <= t) ? (bf16_t)f2bf_sw(w_s[e]) : (bf16_t)0; }
    }
    if (part == 1) {
        const f32x4* ck = (const f32x4*)a.in[2]; const f32x4* cv = (const f32x4*)a.in[3];
        f32x4* ok = (f32x4*)(a.out + O_KS); f32x4* ov = (f32x4*)(a.out + O_VS);
        for (long e0 = gt; e0 < 128L * 127 * 32; e0 += 4 * NT) {
            f32x4 tk[4], tv[4]; long di[4];
#pragma unroll
            for (int q = 0; q < 4; ++q) { const long e = e0 + q * NT; const bool ok_ = e < 128L * 127 * 32; const long ee = ok_ ? e : 0; const long b = ee / (127 * 32), r = ee % (127 * 32); const long j = r >> 5, x = r & 31;
                di[q] = ok_ ? (b * 128 + j) * 32 + x : -1; tk[q] = __builtin_nontemporal_load(ck + (b * 128 + j + 1) * 32 + x); tv[q] = __builtin_nontemporal_load(cv + (b * 128 + j + 1) * 32 + x); }
#pragma unroll
            for (int q = 0; q < 4; ++q) if (di[q] >= 0) { __builtin_nontemporal_store(tk[q], ok + di[q]); __builtin_nontemporal_store(tv[q], ov + di[q]); }
        }
        const f32x4* st = (const f32x4*)a.in[4]; f32x4* oc = (f32x4*)(a.out + O_CS);
        for (long e = gt; e < 128L * 1536; e += NT) { const long b = e / 1536, x = e % 1536; oc[(b * 2 + 0) * 1536 + x] = st[(b * 2 + 1) * 1536 + x]; }
    }
}

__device__ __forceinline__ f32x4 mfma16(bf16x8 a, bf16x8 b, f32x4 c) { return __builtin_amdgcn_mfma_f32_16x16x32_bf16(a, b, c, 0, 0, 0); }

__device__ __forceinline__ void mixer_prompt_unit(const Args& a, unsigned char* lds, int b, int c) {
    unsigned char* ws = a.ws;
    const bf16_t* __restrict__ U = (const bf16_t*)(ws + WS_U); const bf16_t* __restrict__ AV = (const bf16_t*)(ws + WS_AV); const bf16_t* __restrict__ Q = (const bf16_t*)(ws + WS_Q);
    const bf16_t* __restrict__ KB = (const bf16_t*)(ws + WS_KB); const bf16_t* __restrict__ VB = (const bf16_t*)(ws + WS_VB); const bf16_t* __restrict__ WSB = (const bf16_t*)(ws + WS_WSB);
    bf16_t* __restrict__ YA = (bf16_t*)(ws + WS_Y); bf16_t* __restrict__ YB = (bf16_t*)(ws + WS_Y) + 512;
    const int tid = threadIdx.x, lane = tid & 63, w = __builtin_amdgcn_readfirstlane(tid >> 6), l15 = lane & 15, lg = lane >> 4;
    const int r0 = b * 2048 + c * 128;
    float2* MU = (float2*)lds;
    u32x4 vst[8];
#pragma unroll
    for (int it = 0; it < 8; ++it) { const int idx = it * 512 + tid, key = idx >> 4, ch = idx & 15; int kr = r0 - 128 + key; if (c == 0 && key < 128) kr = r0 + key;
        vst[it] = *(const u32x4*)(VB + (size_t)kr * 128 + ch * 8); }
    __syncthreads();
    {
        const int row = tid >> 2, part = tid & 3;
        const u32x4* src = (const u32x4*)(AV + (size_t)(r0 + row) * 512 + part * 128);
        u32x4 v[16]; float s = 0.f;
#pragma unroll
        for (int i = 0; i < 16; ++i) v[i] = src[i];
#pragma unroll
        for (int i = 0; i < 16; ++i)
#pragma unroll
            for (int k = 0; k < 4; ++k) s += bflo(v[i][k]) + bfhi(v[i][k]);
        s += __shfl_xor(s, 1); s += __shfl_xor(s, 2);
        const float mean = s * (1.f / 512.f); float q = 0.f;
#pragma unroll
        for (int i = 0; i < 16; ++i)
#pragma unroll
            for (int k = 0; k < 4; ++k) { const float d0 = bflo(v[i][k]) - mean, d1 = bfhi(v[i][k]) - mean; q += d0 * d0 + d1 * d1; }
        q += __shfl_xor(q, 1); q += __shfl_xor(q, 2);
        if (part == 0) MU[row] = make_float2(mean, rsqrtf(q * (1.f / 512.f) + EPSN));
    }
    __syncthreads();
    {
        const int h = w;
        bf16_t* VT = (bf16_t*)(lds + 1024) + h * (64 * 136);
        u32x4 Uv[8][2];
#pragma unroll
        for (int tt = 0; tt < 8; ++tt)
#pragma unroll
            for (int pr = 0; pr < 2; ++pr) Uv[tt][pr] = *(const u32x4*)(U + (size_t)(r0 + 16 * tt + l15) * 512 + h * 64 + 32 * pr + 8 * lg);
        const int ch = lane & 7;
        const f32x4 g0 = *(const f32x4*)(a.in[7] + h * 64 + ch * 8), g1 = *(const f32x4*)(a.in[7] + h * 64 + ch * 8 + 4);
        const f32x4 b0 = *(const f32x4*)(a.in[8] + h * 64 + ch * 8), b1 = *(const f32x4*)(a.in[8] + h * 64 + ch * 8 + 4);
#pragma unroll 4
        for (int it = 0; it < 16; ++it) {
            const int s = it * 8 + (lane >> 3);
            const u32x4 av = *(const u32x4*)(AV + (size_t)(r0 + s) * 512 + h * 64 + ch * 8);
            const float2 ms = MU[s];
            f32x4 x0 = (f32x4){bflo(av[0]), bfhi(av[0]), bflo(av[1]), bfhi(av[1])}, x1 = (f32x4){bflo(av[2]), bfhi(av[2]), bflo(av[3]), bfhi(av[3])};
            x0 = (x0 - ms.x) * ms.y * g0 + b0; x1 = (x1 - ms.x) * ms.y * g1 + b1;
            bf16_t* vp = VT + (ch * 8) * 136 + s;
#pragma unroll
            for (int i = 0; i < 4; ++i) { vp[i * 136] = f2bf(x0[i]); vp[(i + 4) * 136] = f2bf(x1[i]); }
            if (c == 15) { float* op = a.out + O_GP + (((size_t)b * 128 + s) * 8 + h) * 64 + ch * 8; *(f32x4*)op = x0; *(f32x4*)(op + 4) = x1; }
        }
        __syncthreads();
        const bf16_t* wsb = WSB + (size_t)h * 128 * 128;
        const float* bsh = a.in[10] + h * 128;
#pragma unroll
        for (int tt = 0; tt < 8; ++tt) {
            f32x4 acc[4];
#pragma unroll
            for (int dt = 0; dt < 4; ++dt) acc[dt] = (f32x4){0.f, 0.f, 0.f, 0.f};
            const int nks = (tt >> 1) + 1;
#pragma unroll
            for (int ks = 0; ks < nks; ++ks) {
                const bf16x8 Bf = *(const bf16x8*)(wsb + (16 * tt + l15) * 128 + 32 * ks + 8 * lg);
#pragma unroll
                for (int dt = 0; dt < 4; ++dt) { const bf16x8 Af = *(const bf16x8*)(VT + (32 * (dt >> 1) + 8 * (l15 >> 2) + 4 * (dt & 1) + (l15 & 3)) * 136 + 32 * ks + 8 * lg); acc[dt] = mfma16(Af, Bf, acc[dt]); }
            }
            const int t = 16 * tt + l15; const float bs = bsh[t];
#pragma unroll
            for (int pr = 0; pr < 2; ++pr) {
                const u32x4 uw = Uv[tt][pr];
                const u32x2 lo = pack4(unpack4((u32x2){uw.x, uw.y}) * (acc[2 * pr] + bs)), hi = pack4(unpack4((u32x2){uw.z, uw.w}) * (acc[2 * pr + 1] + bs));
                *(u32x4*)(YA + (size_t)(r0 + t) * 1024 + h * 64 + 32 * pr + 8 * lg) = (u32x4){lo.x, lo.y, hi.x, hi.y};
            }
        }
    }
    __syncthreads();
    const int qhalf = w & 1;
    bf16x8 Kf[10][2], Qf[2];
#define ATT_LOAD(step) do { const int kvh_ = (step) >> 2, qt_ = (step) & 3; const int i0_ = 64 * qhalf + 16 * qt_; const int kt0_ = (i0_ >> 4) < 6 ? (i0_ >> 4) : 6; \
            const bf16_t* qp_ = Q + (size_t)(r0 + i0_ + l15) * 512 + (kvh_ * 4 + (w >> 1)) * 64 + 8 * lg; Qf[0] = *(const bf16x8*)qp_; Qf[1] = *(const bf16x8*)(qp_ + 32); \
            _Pragma("unroll") for (int j = 0; j < 10; ++j) { const int key_ = 16 * (kt0_ + j) + l15; int kr_ = r0 - 128 + key_; if (c == 0 && key_ < 128) kr_ = r0 + key_; \
                const bf16_t* kp_ = KB + (size_t)kr_ * 128 + kvh_ * 64 + 8 * lg; Kf[j][0] = *(const bf16x8*)kp_; Kf[j][1] = *(const bf16x8*)(kp_ + 32); } } while (0)
    ATT_LOAD(0);
    bf16_t* VTa = (bf16_t*)(lds + 1024);
    {
#pragma unroll
        for (int it = 0; it < 8; ++it) {
            const int idx = it * 512 + tid, key = idx >> 4, ch = idx & 15;
            const u32x4 v = vst[it];
            bf16_t* vp = VTa + (size_t)(ch * 8) * 264 + key;
#pragma unroll
            for (int i = 0; i < 4; ++i) { vp[(2 * i) * 264] = (bf16_t)(v[i] & 0xffffu); vp[(2 * i + 1) * 264] = (bf16_t)(v[i] >> 16); }
        }
    }
    __syncthreads();
    {
        for (int step = 0; step < 8; ++step) {
            const int kvh = step >> 2, qt = step & 3, qh = kvh * 4 + (w >> 1);
            const float sink2 = a.in[11][qh] * LOG2E;
            const int i0 = 64 * qhalf + 16 * qt; const int kt0 = (i0 >> 4) < 6 ? (i0 >> 4) : 6;
            f32x4 S[10];
#pragma unroll
            for (int j = 0; j < 10; ++j) { f32x4 sacc = (f32x4){0.f, 0.f, 0.f, 0.f}; sacc = mfma16(Kf[j][0], Qf[0], sacc); sacc = mfma16(Kf[j][1], Qf[1], sacc); S[j] = sacc; }
            if (step < 7) ATT_LOAD(step + 1);
            const int qi = i0 + l15;
            float mx = -INFINITY;
#pragma unroll
            for (int j = 0; j < 10; ++j)
#pragma unroll
                for (int r = 0; r < 4; ++r) {
                    const int kf = 16 * (kt0 + j) + 4 * lg + r;
                    const bool valid = (kf >= qi) && (kf <= qi + 128) && (c > 0 || kf >= 128);
                    const float sv = valid ? S[j][r] : -INFINITY;
                    S[j][r] = sv; mx = fmaxf(mx, sv);
                }
            mx = fmaxf(mx, __shfl_xor(mx, 16)); mx = fmaxf(mx, __shfl_xor(mx, 32));
            mx = fmaxf(mx, sink2);
            float sum = 0.f;
#pragma unroll
            for (int j = 0; j < 10; ++j)
#pragma unroll
                for (int r = 0; r < 4; ++r) { const float pe = __builtin_amdgcn_exp2f(S[j][r] - mx); S[j][r] = pe; sum += pe; }
            sum += __shfl_xor(sum, 16); sum += __shfl_xor(sum, 32);
            const float inv = 1.f / (sum + __builtin_amdgcn_exp2f(sink2 - mx));
            f32x4 O[4];
#pragma unroll
            for (int dt = 0; dt < 4; ++dt) O[dt] = (f32x4){0.f, 0.f, 0.f, 0.f};
#pragma unroll
            for (int kp2 = 0; kp2 < 5; ++kp2) {
                u32x4 pw; pw.x = cvt_pk_bf16(S[2 * kp2][0], S[2 * kp2][1]); pw.y = cvt_pk_bf16(S[2 * kp2][2], S[2 * kp2][3]);
                pw.z = cvt_pk_bf16(S[2 * kp2 + 1][0], S[2 * kp2 + 1][1]); pw.w = cvt_pk_bf16(S[2 * kp2 + 1][2], S[2 * kp2 + 1][3]);
                const bf16x8 Bp = __builtin_bit_cast(bf16x8, pw);
#pragma unroll
                for (int dt = 0; dt < 4; ++dt) {
                    const bf16_t* vp = VTa + (size_t)(kvh * 64 + 32 * (dt >> 1) + 8 * (l15 >> 2) + 4 * (dt & 1) + (l15 & 3)) * 264 + 16 * (kt0 + 2 * kp2) + 4 * lg;
                    const u32x2 lo = *(const u32x2*)vp, hi = *(const u32x2*)(vp + 16);
                    const u32x4 aw = (u32x4){lo.x, lo.y, hi.x, hi.y};
                    O[dt] = mfma16(__builtin_bit_cast(bf16x8, aw), Bp, O[dt]);
                }
            }
#pragma unroll
            for (int pr = 0; pr < 2; ++pr) { const u32x2 lo = pack4(O[2 * pr] * inv), hi = pack4(O[2 * pr + 1] * inv);
                *(u32x4*)(YB + (size_t)(r0 + qi) * 1024 + qh * 64 + 32 * pr + 8 * lg) = (u32x4){lo.x, lo.y, hi.x, hi.y}; }
        }
#undef ATT_LOAD
    }
    __syncthreads();
}

__device__ __forceinline__ void mixer_sample_token(const Args& a, unsigned char* lds, int bs) {
    unsigned char* ws = a.ws;
    const bf16_t* U = (const bf16_t*)(ws + WS_U); const bf16_t* AV = (const bf16_t*)(ws + WS_AV); const bf16_t* Q = (const bf16_t*)(ws + WS_Q);
    const bf16_t* KB = (const bf16_t*)(ws + WS_KB); const bf16_t* VB = (const bf16_t*)(ws + WS_VB);
    bf16_t* YA = (bf16_t*)(ws + WS_Y); bf16_t* YB = YA + 512;
    const int tid = threadIdx.x, lane = tid & 63, w = __builtin_amdgcn_readfirstlane(tid >> 6);
    const size_t row = (size_t)MP + bs;
    __syncthreads();
    {
        const u32x4 av = *(const u32x4*)(AV + row * 512 + lane * 8);
        float x[8] = {bflo(av[0]), bfhi(av[0]), bflo(av[1]), bfhi(av[1]), bflo(av[2]), bfhi(av[2]), bflo(av[3]), bfhi(av[3])};
        float s = 0.f;
#pragma unroll
        for (int i = 0; i < 8; ++i) s += x[i];
        const float mean = wave_sum(s) * (1.f / 512.f); float q = 0.f;
#pragma unroll
        for (int i = 0; i < 8; ++i) { const float d = x[i] - mean; q += d * d; }
        const float rstd = rsqrtf(wave_sum(q) * (1.f / 512.f) + EPSN);
        const int h = w, col = h * 64 + lane;
        const float xv = bf2f(AV[row * 512 + col]);
        const float vg = (xv - mean) * rstd * a.in[7][col] + a.in[8][col];
        a.out[O_GS + (size_t)bs * 512 + col] = vg;
        const float mix = a.in[9][(size_t)h * 128 * 128] * vg + a.in[10][h * 128];
        YA[row * 1024 + col] = f2bf(bf2f(U[row * 512 + col]) * mix);
    }
    {
        const int qh = w, kvh = qh >> 2;
        float qv[64];
#pragma unroll
        for (int i = 0; i < 8; ++i) { const u32x4 qq = *(const u32x4*)(Q + row * 512 + qh * 64 + i * 8);
#pragma unroll
            for (int k = 0; k < 4; ++k) { qv[i * 8 + 2 * k] = bflo(qq[k]); qv[i * 8 + 2 * k + 1] = bfhi(qq[k]); } }
        const float* ck = a.in[2] + ((size_t)bs * 128) * 128 + kvh * 64;
        const float* cv = a.in[3] + ((size_t)bs * 128) * 128 + kvh * 64;
        float s0 = 0.f, s1 = 0.f, sn = 0.f;
#pragma unroll
        for (int i = 0; i < 16; ++i) {
            const f32x4 k0 = *(const f32x4*)(ck + (size_t)lane * 128 + 4 * i), k1 = *(const f32x4*)(ck + (size_t)(lane + 64) * 128 + 4 * i);
#pragma unroll
            for (int k = 0; k < 4; ++k) { s0 += qv[4 * i + k] * k0[k]; s1 += qv[4 * i + k] * k1[k]; }
        }
#pragma unroll
        for (int i = 0; i < 8; ++i) { const u32x4 kk = *(const u32x4*)(KB + row * 128 + kvh * 64 + i * 8);
#pragma unroll
            for (int k = 0; k < 4; ++k) sn += qv[i * 8 + 2 * k] * bflo(kk[k]) + qv[i * 8 + 2 * k + 1] * bfhi(kk[k]); }
        const float sink2 = a.in[11][qh] * LOG2E;
        float mx = wave_max(fmaxf(s0, s1)); mx = fmaxf(fmaxf(mx, sn), sink2);
        const float p0 = __builtin_amdgcn_exp2f(s0 - mx), p1 = __builtin_amdgcn_exp2f(s1 - mx), pn = __builtin_amdgcn_exp2f(sn - mx);
        const float denom = wave_sum(p0 + p1) + pn + __builtin_amdgcn_exp2f(sink2 - mx);
        float* P = (float*)(lds + 1024) + w * 128;
        P[lane] = p0; P[lane + 64] = p1;
        __syncthreads();
        float o = pn * bf2f(VB[row * 128 + kvh * 64 + lane]);
#pragma unroll 8
        for (int j = 0; j < 128; ++j) o += P[j] * cv[(size_t)j * 128 + lane];
        YB[row * 1024 + qh * 64 + lane] = f2bf(o / denom);
    }
    __syncthreads();
}

__device__ __forceinline__ f32x4 fixup_item(const float* HEAD, const float* TAIL, const float* cw, const float* cb, long e, size_t& oidx) {
    const int cg4 = (int)(e % 768), rr = (int)(e / 768) & 1, blk = (int)(e / 1536);
    const int col = cg4 * 4; oidx = ((size_t)blk * 64 + rr) * 3072 + col;
    const bool first = ((blk * 64) & 2047) == 0;
    f32x4 cc[2];
#pragma unroll
    for (int hf = 0; hf < 2; ++hf) {
        const int ac = hf * 3072 + col;
        const f32x4 w0 = *(const f32x4*)(cw + ac), w1 = *(const f32x4*)(cw + 6144 + ac), w2 = *(const f32x4*)(cw + 12288 + ac), b0 = *(const f32x4*)(cb + ac);
        const f32x4 h0 = *(const f32x4*)(HEAD + ((size_t)blk * 2 + 0) * 6144 + ac), h1 = *(const f32x4*)(HEAD + ((size_t)blk * 2 + 1) * 6144 + ac);
        const int pb = first ? blk : blk - 1;
        f32x4 t0 = *(const f32x4*)(TAIL + ((size_t)pb * 2 + 0) * 6144 + ac), t1 = *(const f32x4*)(TAIL + ((size_t)pb * 2 + 1) * 6144 + ac);
        if (first) { t0 = (f32x4){0.f, 0.f, 0.f, 0.f}; t1 = t0; }
        cc[hf] = rr == 0 ? (b0 + w0 * t0 + w1 * t1 + w2 * h0) : (b0 + w0 * t1 + w1 * h0 + w2 * h1);
    }
    f32x4 r;
#pragma unroll
    for (int j = 0; j < 4; ++j) r[j] = gelu_t(cc[0][j]) * cc[1][j];
    return r;
}
__device__ __forceinline__ void conv_fixup(const Args& a, int G) {
    unsigned char* ws = a.ws;
    const float* HEAD = (const float*)(ws + WS_HEAD); const float* TAIL = (const float*)(ws + WS_TAIL); bf16_t* ACT = (bf16_t*)(ws + WS_ACT);
    const float* cw = a.in[17]; const float* cb = a.in[18];
    const long gt = (long)blockIdx.x * 512 + threadIdx.x, NT = (long)G * 512, NE = 512L * 2 * 768;
    for (long e0 = gt; e0 < NE; e0 += 3 * NT) {
        f32x4 r[3]; size_t oi[3]; bool okq[3];
#pragma unroll
        for (int q = 0; q < 3; ++q) { const long e = e0 + q * NT; okq[q] = e < NE; r[q] = fixup_item(HEAD, TAIL, cw, cb, okq[q] ? e : e0, oi[q]); }
#pragma unroll
        for (int q = 0; q < 3; ++q) if (okq[q]) *(u32x2*)(ACT + oi[q]) = pack4(r[q]);
    }
}
__device__ __forceinline__ void final_norm(const Args& a, int vcu, int G) {
    const int tid = threadIdx.x, lane = tid & 63, wave = tid >> 6;
    const float* ssq2 = (const float*)(a.ws + WS_SSQ2); const float* g = a.in[20]; const bf16_t* X2B = (const bf16_t*)(a.ws + WS_X2B);
    f32x4 gg[4];
#pragma unroll
    for (int j = 0; j < 4; ++j) gg[j] = ((const f32x4*)g)[64 * j + lane];
    for (int ch = vcu * 8 + wave; ch < MTOT / 4; ch += G * 8) {
        const int rowc = ch * 4;
        u32x2 v[4][4]; float sq[4];
#pragma unroll
        for (int r = 0; r < 4; ++r) {
            sq[r] = ssq2[(size_t)(rowc + r) * 16 + (lane & 15)];
#pragma unroll
            for (int j = 0; j < 4; ++j) v[r][j] = __builtin_nontemporal_load(((const u32x2*)(X2B + (size_t)(rowc + r) * 1024)) + 64 * j + lane);
        }
#pragma unroll
        for (int r = 0; r < 4; ++r) {
            float s = sq[r];
            s += __shfl_xor(s, 1); s += __shfl_xor(s, 2); s += __shfl_xor(s, 4); s += __shfl_xor(s, 8);
            const float rstd = rsqrtf(s * (1.f / 1024.f) + EPSN);
#pragma unroll
            for (int j = 0; j < 4; ++j) __builtin_nontemporal_store(unpack4(v[r][j]) * rstd * gg[j], ((f32x4*)(a.out + (size_t)(rowc + r) * 1024)) + 64 * j + lane);
        }
    }
}

__device__ __forceinline__ void skinny_tile(const bf16_t* A, int lda, const bf16_t* Bt, int ldb, int K, int row0, int colA0, int colB0, float* red, float* tile) {
    const int tid = threadIdx.x, lane = tid & 63, w = __builtin_amdgcn_readfirstlane(tid >> 6), l15 = lane & 15, lg = lane >> 4;
    f32x4 acc[4];
#pragma unroll
    for (int n = 0; n < 4; ++n) acc[n] = (f32x4){0.f, 0.f, 0.f, 0.f};
    const bf16_t* ap = A + (size_t)(row0 + l15) * lda + 8 * lg;
    const bf16_t* bp0 = Bt + (size_t)(colA0 + l15) * ldb + 8 * lg;
    const bf16_t* bp1 = Bt + (size_t)(colA0 + 16 + l15) * ldb + 8 * lg;
    const bf16_t* bp2 = Bt + (size_t)(colB0 + l15) * ldb + 8 * lg;
    const bf16_t* bp3 = Bt + (size_t)(colB0 + 16 + l15) * ldb + 8 * lg;
    const int nks = K >> 5;
#pragma unroll 2
    for (int ks = w; ks < nks; ks += 8) {
        const bf16x8 Af = *(const bf16x8*)(ap + 32 * ks);
        const bf16x8 B0 = *(const bf16x8*)(bp0 + 32 * ks), B1 = *(const bf16x8*)(bp1 + 32 * ks), B2 = *(const bf16x8*)(bp2 + 32 * ks), B3 = *(const bf16x8*)(bp3 + 32 * ks);
        acc[0] = mfma16(Af, B0, acc[0]); acc[1] = mfma16(Af, B1, acc[1]); acc[2] = mfma16(Af, B2, acc[2]); acc[3] = mfma16(Af, B3, acc[3]);
    }
    __syncthreads();
#pragma unroll
    for (int n = 0; n < 4; ++n)
#pragma unroll
        for (int r = 0; r < 4; ++r) red[w * 1024 + (4 * lg + r) * 64 + 16 * n + l15] = acc[n][r];
    __syncthreads();
#pragma unroll
    for (int h = 0; h < 2; ++h) { const int e = tid + 512 * h; float s = 0.f;
#pragma unroll
        for (int k = 0; k < 8; ++k) s += red[k * 1024 + e];
        tile[e] = s; }
    __syncthreads();
}
__device__ __forceinline__ void sample_p3(const Args& a, unsigned char* lds, int G) {
    unsigned char* ws = a.ws; float* red = (float*)lds; float* tA = (float*)(lds + 32768); float* tB = (float*)(lds + 36864);
    const bf16_t* SA = (const bf16_t*)(ws + WS_SA); const bf16_t* SB = (const bf16_t*)(ws + WS_SB); bf16_t* MG = (bf16_t*)(ws + WS_MG);
    for (int p = blockIdx.x; p < 128; p += G) {
        const int rg = p & 7, cgp = p >> 3, row0 = MP + 16 * rg, col0 = 64 * cgp;
        skinny_tile((const bf16_t*)(ws + WS_Y), 1024, (const bf16_t*)(ws + WS_WPA), 1024, 512, row0, col0, col0 + 32, red, tA);
        skinny_tile((const bf16_t*)(ws + WS_Y) + 512, 1024, (const bf16_t*)(ws + WS_WPA) + 512, 1024, 512, row0, col0, col0 + 32, red, tB);
#pragma unroll
        for (int h = 0; h < 2; ++h) { const int e = threadIdx.x + 512 * h; const size_t off = (size_t)(row0 + (e >> 6)) * 1024 + col0 + (e & 63);
            MG[off] = f2bf(bf2f(SB[off]) * (bf2f(SA[off]) * tA[e] + tB[e])); }
    }
}
__device__ __forceinline__ void sample_res(const Args& a, unsigned char* lds, int G, const bf16_t* A, int K, const bf16_t* Bt, const float* basef, const bf16_t* baseb, bf16_t* XB, float* ssq) {
    float* red = (float*)lds; float* tl = (float*)(lds + 32768);
    for (int p = blockIdx.x; p < 128; p += G) {
        const int rg = p & 7, cgp = p >> 3, row0 = MP + 16 * rg, col0 = 64 * cgp;
        skinny_tile(A, K, Bt, K, K, row0, col0, col0 + 32, red, tl);
#pragma unroll
        for (int h = 0; h < 2; ++h) { const int e = threadIdx.x + 512 * h; const int row = row0 + (e >> 6), col = col0 + (e & 63);
            const float bs = baseb ? bf2f(baseb[(size_t)row * 1024 + col]) : basef[(size_t)(row - MP) * 1024 + col];
            const float v = bs + tl[e];
            XB[(size_t)row * 1024 + col] = f2bf(v);
            const float q = wave_sum(v * v);
            if ((threadIdx.x & 63) == 0) ssq[(size_t)row * 16 + cgp] = q; }
    }
}
__device__ __forceinline__ void sample_up(const Args& a, unsigned char* lds, int G) {
    unsigned char* ws = a.ws; float* red = (float*)lds; float* tl = (float*)(lds + 32768);
    const float* ssq1 = (const float*)(ws + WS_SSQ1); const float* cw = a.in[17]; const float* cb = a.in[18]; const float* st = a.in[4]; bf16_t* ACT = (bf16_t*)(ws + WS_ACT);
    for (int p = blockIdx.x; p < 768; p += G) {
        const int rg = p & 7, rest = p >> 3, qq = rest & 3, pn = rest >> 2, row0 = MP + 16 * rg;
        skinny_tile((const bf16_t*)(ws + WS_X1B), 1024, (const bf16_t*)(ws + WS_WUP), 1024, 1024, row0, 256 * pn + 32 * qq, 256 * pn + 128 + 32 * qq, red, tl);
        const int t = threadIdx.x, r = t >> 5, c = t & 31, row = row0 + r, bs = row - MP, ac = 128 * pn + 32 * qq + c, bc = 3072 + ac;
        float ss = 0.f;
#pragma unroll
        for (int k = 0; k < 16; ++k) ss += ssq1[(size_t)row * 16 + k];
        const float rstd = rsqrtf(ss * (1.f / 1024.f) + EPSN);
        const float za = tl[r * 64 + c] * rstd, zb = tl[r * 64 + 32 + c] * rstd;
        a.out[O_CS + ((size_t)bs * 2 + 1) * 6144 + ac] = za; a.out[O_CS + ((size_t)bs * 2 + 1) * 6144 + bc] = zb;
        const float ca = cb[ac] + cw[ac] * st[((size_t)bs * 2) * 6144 + ac] + cw[6144 + ac] * st[((size_t)bs * 2 + 1) * 6144 + ac] + cw[12288 + ac] * za;
        const float cb2 = cb[bc] + cw[bc] * st[((size_t)bs * 2) * 6144 + bc] + cw[6144 + bc] * st[((size_t)bs * 2 + 1) * 6144 + bc] + cw[12288 + bc] * zb;
        ACT[(size_t)row * 3072 + ac] = f2bf(gelu_t(ca) * cb2);
    }
}

#define XB_TMO      128
#define XB_XCNT(j)  (256  + 64 * (j))
#define XB_XSUB(j)  (1280 + 64 * (j))
#define XB_XGEN(j)  (2304 + 64 * (j))
#define XB_TOP      3328
#define XB_TOPGEN   3392
#define XCD_BAR_WORDS 3456
#define XB_SPIN_CAP (1u << 18)

__device__ __forceinline__ unsigned xb_ld(unsigned* p)              { return __hip_atomic_load(p, __ATOMIC_RELAXED, __HIP_MEMORY_SCOPE_AGENT); }
__device__ __forceinline__ unsigned xb_add(unsigned* p, unsigned v) { return __hip_atomic_fetch_add(p, v, __ATOMIC_RELAXED, __HIP_MEMORY_SCOPE_AGENT); }
__device__ __forceinline__ unsigned xb_xcc_id() { return (unsigned)__builtin_amdgcn_s_getreg((3 << 11) | 20) & 0xFu; }
#define XB_SPIN(cond, bar) do { unsigned _sp = 0; while (cond) { __builtin_amdgcn_s_sleep(1); \
    if ((++_sp & 255u) == 0u) { if (xb_ld(&(bar)[XB_TMO])) break; if (_sp > XB_SPIN_CAP) { atomicAdd(&(bar)[XB_TMO], 1u); break; } } } } while (0)

struct XcdBarrier {
    unsigned* bar; unsigned x;
    volatile LAS unsigned* st;
};

__device__ __forceinline__ XcdBarrier xcd_barrier_post(unsigned* bar, volatile LAS unsigned* st) {
    XcdBarrier b; b.bar = bar; b.x = xb_xcc_id(); b.st = st;
    if (threadIdx.x == 0) (void)xb_add(&bar[XB_XCNT(b.x)], 1u);
    return b;
}
__device__ __forceinline__ void xcd_barrier_complete(unsigned* bar, unsigned x, unsigned& nloc, unsigned& nx) {
    const unsigned G = gridDim.x * gridDim.y * gridDim.z;
    unsigned sum, cnt, mine, sp = 0u;
    for (;;) {
        sum = 0u; cnt = 0u; mine = 0u;
#pragma unroll
        for (unsigned j = 0; j < 16; ++j) { const unsigned c = xb_ld(&bar[XB_XCNT(j)]); sum += c; cnt += (c > 0u) ? 1u : 0u; mine = (j == x) ? c : mine; }
        if (sum == G) break;
        __builtin_amdgcn_s_sleep(1);
        if ((++sp & 255u) == 0u) { if (xb_ld(&bar[XB_TMO])) break; if (sp > XB_SPIN_CAP) { atomicAdd(&bar[XB_TMO], 1u); break; } }
    }
    nloc = mine > 0u ? mine : 1u; nx = cnt > 0u ? cnt : 1u;
}

__device__ __forceinline__ void xcd_barrier(const XcdBarrier& b) {
    asm volatile("s_waitcnt vmcnt(0)" ::: "memory");
    __syncthreads();
    if (threadIdx.x == 0) {
        unsigned* bar = b.bar;
        __builtin_amdgcn_s_waitcnt(0);
        unsigned nloc = b.st[0], nx = b.st[1];
        if (nloc == 0u) { xcd_barrier_complete(bar, b.x, nloc, nx); b.st[0] = nloc; b.st[1] = nx; }
        const unsigned old = xb_add(&bar[XB_XSUB(b.x)], 1u);
        const unsigned gen = old / nloc;
        if (old + 1u == (gen + 1u) * nloc) {
            __builtin_amdgcn_fence(__ATOMIC_RELEASE, "agent");
            asm volatile("s_waitcnt vmcnt(0)" ::: "memory");
            const unsigned og = xb_add(&bar[XB_TOP], 1u);
            const unsigned tg = og / nx;
            if (og + 1u == (tg + 1u) * nx) xb_add(&bar[XB_TOPGEN], 1u);
            else XB_SPIN(xb_ld(&bar[XB_TOPGEN]) == tg, bar);
            __builtin_amdgcn_fence(__ATOMIC_ACQUIRE, "agent");
            xb_add(&bar[XB_XGEN(b.x)], 1u);
            asm volatile("s_waitcnt vmcnt(0)" ::: "memory");
        } else {
            XB_SPIN(xb_ld(&bar[XB_XGEN(b.x)]) == gen, bar);
            __builtin_amdgcn_fence(__ATOMIC_ACQUIRE, "agent");
            asm volatile("s_waitcnt vmcnt(0)" ::: "memory");
        }
    }
    __syncthreads();
}

__global__ void __launch_bounds__(512, 2) fwd_mega(Args a) {
    extern __shared__ __attribute__((aligned(16))) unsigned char lds[];
    cg::grid_group grid = cg::this_grid();
    LAS unsigned char* ldsl = (LAS unsigned char*)lds;
    const int G = gridDim.x, bx = blockIdx.x;
    const int vcu = (G % 8 == 0) ? (bx % 8) * (G / 8) + bx / 8 : bx;
    unsigned char* ws = a.ws;
    bf16_t* XN = (bf16_t*)(ws + WS_XN); bf16_t* Ub = (bf16_t*)(ws + WS_U); bf16_t* AVb = (bf16_t*)(ws + WS_AV); bf16_t* Qb = (bf16_t*)(ws + WS_Q);
    bf16_t* KBb = (bf16_t*)(ws + WS_KB); bf16_t* VBb = (bf16_t*)(ws + WS_VB); bf16_t* SAb = (bf16_t*)(ws + WS_SA); bf16_t* SBb = (bf16_t*)(ws + WS_SB);
    bf16_t* MGb = (bf16_t*)(ws + WS_MG);
    bf16_t* X1B = (bf16_t*)(ws + WS_X1B); bf16_t* ACTb = (bf16_t*)(ws + WS_ACT);
    float* SSQ1 = (float*)(ws + WS_SSQ1); float* SSQ2 = (float*)(ws + WS_SSQ2);

    volatile LAS unsigned* MISC = (volatile LAS unsigned*)(ldsl + LDS_BYTES - 64);
    if (threadIdx.x < 16) MISC[threadIdx.x] = 0u;
    unsigned* barw = (unsigned*)ws;
    __syncthreads();
    XcdBarrier bar = xcd_barrier_post(barw, MISC);
    if (a.dbg) grid.sync();
    p0_prologue(a, ldsl, 0, vcu, G);
    xcd_barrier(bar);
    {
        pg8::Gemm g{XN, (const bf16_t*)(ws + WS_WIN), MPAD, NIN, 1024}; pg8::StaticOrder S; S.init(MPAD, NIN, G, bx);
        EpiIn E{Ub, AVb, Qb, KBb, VBb, SAb, SBb, (const float*)(ws + WS_ROPE), a.out};
        pg8::gemm_phase<EpiIn, pg8::StaticOrder, true, true>(ldsl, g, S, E);
    }
    {
        const int nwg1 = (MPAD / 256) * (NIN / 256), nfull = nwg1 % G;
        if (nfull == 0) p0_prologue(a, ldsl, 1, bx, G); else if (bx >= nfull) p0_prologue(a, ldsl, 1, bx - nfull, G - nfull);
    }
    xcd_barrier(bar);
    for (int unit = vcu; unit < 256; unit += G) mixer_prompt_unit(a, lds, unit >> 4, unit & 15);
    for (int tk = bx; tk < MS; tk += G) mixer_sample_token(a, lds, tk);
    xcd_barrier(bar);
    {
    {
        pg8::Gemm g{(const bf16_t*)(ws + WS_Y), (const bf16_t*)(ws + WS_WPA), MP, 1024, 512, 1024, 1024}; pg8::SplitOrder S; S.init(MP, 1024, G, bx);
        EpiGate E{SAb, SBb, MGb};
        pg8::gemm_phase<EpiGate, pg8::SplitOrder, true, true>(ldsl, g, S, E);
    }
    sample_p3(a, lds, G);
    }
    xcd_barrier(bar);
    {
        pg8::Gemm g{MGb, (const bf16_t*)(ws + WS_WO), MP, 1024, 1024}; pg8::StaticOrder S; S.init(MP, 1024, G, bx);
        EpiRes E{a.in[0], nullptr, X1B, SSQ1};
        pg8::gemm_phase<EpiRes, pg8::StaticOrder, true, true>(ldsl, g, S, E);
        sample_res(a, lds, G, MGb, 1024, (const bf16_t*)(ws + WS_WO), a.in[1], nullptr, X1B, SSQ1);
    }
    xcd_barrier(bar);
    {
        pg8::Gemm g{X1B, (const bf16_t*)(ws + WS_WUP), MP, NUP, 1024}; pg8::StaticOrder S; S.init(MP, NUP, G, bx);
        EpiUp E{SSQ1, a.in[17], a.in[18], ACTb, (float*)(ws + WS_HEAD), (float*)(ws + WS_TAIL), a.out, (LAS float*)(ldsl + 131072)};
        pg8::gemm_phase<EpiUp, pg8::StaticOrder, true, true>(ldsl, g, S, E);
        sample_up(a, lds, G);
    }
    xcd_barrier(bar);
    conv_fixup(a, G);
    xcd_barrier(bar);
    {
        pg8::Gemm g{ACTb, (const bf16_t*)(ws + WS_WDN), MP, 1024, 3072}; pg8::StaticOrder S; S.init(MP, 1024, G, bx);
        EpiRes E{nullptr, X1B, (bf16_t*)(ws + WS_X2B), SSQ2};
        pg8::gemm_phase<EpiRes, pg8::StaticOrder, true, true>(ldsl, g, S, E);
        sample_res(a, lds, G, ACTb, 3072, (const bf16_t*)(ws + WS_WDN), nullptr, X1B, (bf16_t*)(ws + WS_X2B), SSQ2);
    }
    xcd_barrier(bar);
    final_norm(a, vcu, G);
}

extern "C" void kernel_launch(void* const* d_in, const int* in_sizes, int n_in, void* d_out, int out_size, void* d_ws, size_t ws_size, hipStream_t stream) {
    static int grid = 0;
    if (grid == 0) {
        if (n_in != 21 || out_size != (int)O_END || ws_size < WS_END) { fprintf(stderr, "kernel_launch: unexpected shapes n_in %d out %d ws %zu\n", n_in, out_size, ws_size); grid = -1; return; }
        int dev = 0, cus = 0, per_cu = 0;
        if (hipGetDevice(&dev) != hipSuccess || hipDeviceGetAttribute(&cus, hipDeviceAttributeMultiprocessorCount, dev) != hipSuccess) { grid = -1; return; }
        if (hipFuncSetAttribute((const void*)fwd_mega, hipFuncAttributeMaxDynamicSharedMemorySize, LDS_BYTES) != hipSuccess) { grid = -1; return; }
        if (hipOccupancyMaxActiveBlocksPerMultiprocessor(&per_cu, (const void*)fwd_mega, 512, LDS_BYTES) != hipSuccess || per_cu < 1) { fprintf(stderr, "occupancy query: %d\n", per_cu); }
        (void)hipGetLastError();
        grid = cus;
    }
    if (grid < 0) return;
    if (hipMemsetAsync(d_ws, 0, 32768, stream) != hipSuccess) { fprintf(stderr, "kernel_launch: memset failed\n"); return; }
    Args a{};
    for (int i = 0; i < 21; ++i) a.in[i] = (const float*)d_in[i];
    a.out = (float*)d_out; a.ws = (unsigned char*)d_ws; a.dbg = 0; a.pad = 0;
    void* args[] = {&a};
    hipError_t e = hipLaunchCooperativeKernel((void*)fwd_mega, dim3(grid), dim3(512), args, LDS_BYTES, stream);
    if (e != hipSuccess) fprintf(stderr, "cooperative launch failed: %s (grid %d)\n", hipGetErrorString(e), grid);
}
```

```cpp
#include <hip/hip_runtime.h>
#include <hip/hip_cooperative_groups.h>
#include <cstdio>
#include <cstdint>
namespace cg = cooperative_groups;
namespace pg8 {
#define PG8_LAS __attribute__((address_space(3)))
typedef unsigned short bf16_t;
typedef short bf16x8 __attribute__((ext_vector_type(8)));
typedef float f32x4 __attribute__((ext_vector_type(4)));
typedef unsigned u32x4 __attribute__((ext_vector_type(4)));
constexpr int BM = 256, BK = 64, HALF = 128, HTB = HALF * BK * 2  , STAGE_BYTES = 8 * HTB, NXCD = 8, WGM = 8;

__host__ __device__ __forceinline__ int lds_byte(int r, int c) { const int st = (r >> 4) * 2 + (c >> 5), rr = r & 15, cc = c & 31, ob = rr * 64 + cc * 2; return st * 1024 + (ob ^ (((ob >> 9) & 1) << 5)); }
__host__ __device__ __forceinline__ void stage_rc(int b, int& R, int& C) { const int st = b / 1024, sb = b % 1024, swz = sb ^ (((sb >> 9) & 1) << 5); R = (st >> 1) * 16 + swz / 64; C = (st & 1) * 32 + (swz % 64) / 2; }
__host__ __device__ __forceinline__ int perm32(int rho) { const int n = rho >> 4, i = rho & 15; return 8 * (i >> 2) + 4 * n + (i & 3); }

struct Unit { int pm, pn, kh; };
struct Gemm { const bf16_t* A; const bf16_t* Bt; int M, N, K; int lda, ldb; };

struct StaticOrder {
    int nM, nN, nwg, G, c;
    __host__ __device__ void init(int M, int N, int G_, int c_) { nM = M / BM; nN = N / BM; nwg = nM * nN; G = G_; c = c_; }
    __host__ __device__ bool next(int i, Unit& u) const {
        const long L = (long)i * G + c; if (L >= nwg) return false;
        int wgid = (int)L; { const int q = nwg / NXCD, r = nwg % NXCD, xcd = wgid % NXCD, off = wgid / NXCD; wgid = (xcd < r ? xcd * (q + 1) : r * (q + 1) + (xcd - r) * q) + off; }
        const int nig = WGM * nN, gid = wgid / nig, fm = gid * WGM, gsz = (nM - fm) < WGM ? (nM - fm) : WGM;
        u.pm = fm + ((wgid % nig) % gsz); u.pn = (wgid % nig) / gsz; u.kh = 0; return true;
    }
    __device__ __forceinline__ void a_ready(const Unit&) const {}
    __device__ __forceinline__ void done(const Unit&) const {}
};
struct SplitOrder {
    StaticOrder b;
    __host__ __device__ void init(int M, int N, int G_, int c_) { b.init(M, N, G_, c_); }
    __host__ __device__ bool next(int i, Unit& u) const { if (!b.next(i >> 1, u)) return false; u.kh = i & 1; return true; }
    __device__ __forceinline__ void a_ready(const Unit&) const {}
    __device__ __forceinline__ void done(const Unit&) const {}
};
__device__ __forceinline__ unsigned cvt_pk_bf16(float lo, float hi) { unsigned r; asm volatile("v_cvt_pk_bf16_f32 %0, %1, %2" : "=v"(r) : "v"(lo), "v"(hi)); return r; }
typedef float f32x2 __attribute__((ext_vector_type(2)));
template <class Epi, class Sched, bool ALIGN_EPI = false, bool SP2 = false>
__device__ __forceinline__ void gemm_phase(PG8_LAS unsigned char* lds, const Gemm g, const Sched& S, const Epi& E) {
    const int tid = threadIdx.x, wid = __builtin_amdgcn_readfirstlane(tid >> 6), lane = tid & 63, wr = wid >> 2, wc = wid & 3, fr = lane & 15, fq = lane >> 4;
    const int K = g.K, nt = K / BK;
    const int lda = g.lda ? g.lda : K, ldb = g.ldb ? g.ldb : K;
    unsigned voffA[2], voffB[2];
#pragma unroll
    for (int i = 0; i < 2; ++i) { int R, C; stage_rc(tid * 16 + i * 8192, R, C); const int Rb = Epi::PERM ? ((R & ~31) + perm32(R & 31)) : R;
        voffA[i] = (unsigned)(R * lda + C) * 2u; voffB[i] = (unsigned)(Rb * ldb + C) * 2u; }
    const size_t kstep = (size_t)(BK * 2);
    const size_t hstepA = (size_t)HALF * lda * 2, hstepB = (size_t)HALF * ldb * 2, khoff = (size_t)K * 2;
    const size_t tstepA = 2 * hstepA, tstepB = 2 * hstepB;
    const unsigned ldsw = (unsigned)wid * 1024u;
    const int aoff = lds_byte(wr * 64 + fr, fq * 8), boff = lds_byte(wc * 32 + fr, fq * 8);
#define PG8_SA(b, h) (((b) * 2 + (h)) * HTB)
#define PG8_SB(b, h) ((4 + (b) * 2 + (h)) * HTB)
#define PG8_STAGE(bufoff, gbase, voff) do { _Pragma("unroll") for (int _i = 0; _i < 2; ++_i) \
        __builtin_amdgcn_global_load_lds((const unsigned*)((const char*)(gbase) + (voff)[_i]), (PG8_LAS unsigned*)(lds + (bufoff) + ldsw + _i * 8192), 16, 0, 0); } while (0)
#define PG8_LDA(dst, b, h) do { _Pragma("unroll") for (int m = 0; m < 4; ++m) _Pragma("unroll") for (int k = 0; k < 2; ++k) dst[m][k] = *(const PG8_LAS bf16x8*)(lds + PG8_SA(b, h) + aoff + m * 2048 + k * 1024); } while (0)
#define PG8_LDB(dst, b, h) do { _Pragma("unroll") for (int n = 0; n < 2; ++n) _Pragma("unroll") for (int k = 0; k < 2; ++k) dst[n][k] = *(const PG8_LAS bf16x8*)(lds + PG8_SB(b, h) + boff + n * 2048 + k * 1024); } while (0)
#define PG8_MMA(ai, bj, At, Bt) do { __builtin_amdgcn_s_setprio(1); _Pragma("unroll") for (int m = 0; m < 4; ++m) _Pragma("unroll") for (int n = 0; n < 2; ++n) _Pragma("unroll") for (int k = 0; k < 2; ++k) \
        acc[ai][bj][m][n] = __builtin_amdgcn_mfma_f32_16x16x32_bf16(Bt[n][k], At[m][k], acc[ai][bj][m][n], 0, 0, 0); __builtin_amdgcn_s_setprio(0); } while (0)
#define PG8_WAIT_V(n) asm volatile("s_waitcnt vmcnt(" #n ")" ::: "memory")
#define PG8_WAIT_L(n) asm volatile("s_waitcnt lgkmcnt(" #n ")" ::: "memory")
#define PG8_BAR __builtin_amdgcn_s_barrier()
#define PG8_SCHED __builtin_amdgcn_sched_barrier(0)
    Unit cur, nxt; int ui = 0;
    if (!S.next(0, cur)) return;
    f32x4 acc[2][2][4][2];
#pragma unroll
    for (int a = 0; a < 2; ++a)
#pragma unroll
        for (int b = 0; b < 2; ++b)
#pragma unroll
            for (int m = 0; m < 4; ++m)
#pragma unroll
                for (int n = 0; n < 2; ++n) acc[a][b][m][n] = (f32x4){0.f, 0.f, 0.f, 0.f};
    bf16x8 At[4][2], B0[2][2], B1[2][2];
    const char* cA = (const char*)g.A + (size_t)cur.pm * tstepA + (size_t)cur.kh * khoff; const char* cB = (const char*)g.Bt + (size_t)cur.pn * tstepB + (size_t)cur.kh * khoff;
    S.a_ready(cur);
    if constexpr (SP2) {
        PG8_STAGE(PG8_SB(0, 0), cB, voffB); PG8_STAGE(PG8_SB(0, 1), cB + hstepB, voffB); PG8_STAGE(PG8_SA(0, 0), cA, voffA); PG8_STAGE(PG8_SA(0, 1), cA + hstepA, voffA);
        if (wr == 1) PG8_BAR;
        PG8_WAIT_V(2); PG8_BAR;
        PG8_STAGE(PG8_SB(1, 0), cB + kstep, voffB); PG8_STAGE(PG8_SA(1, 0), cA + kstep, voffA); PG8_STAGE(PG8_SB(1, 1), cB + hstepB + kstep, voffB);
        PG8_WAIT_V(6); PG8_BAR;
    } else {
        PG8_STAGE(PG8_SB(0, 0), cB, voffB); PG8_STAGE(PG8_SA(0, 0), cA, voffA); PG8_STAGE(PG8_SB(0, 1), cB + hstepB, voffB); PG8_STAGE(PG8_SA(0, 1), cA + hstepA, voffA);
        if (wr == 1) PG8_BAR;
        PG8_WAIT_V(4); PG8_BAR;
        PG8_STAGE(PG8_SB(1, 0), cB + kstep, voffB); PG8_STAGE(PG8_SA(1, 0), cA + kstep, voffA); PG8_STAGE(PG8_SB(1, 1), cB + hstepB + kstep, voffB);
        PG8_WAIT_V(6); PG8_BAR;
    }
    for (;;) {
        const bool has_next = S.next(ui + 1, nxt);
        const char* nA = has_next ? (const char*)g.A + (size_t)nxt.pm * tstepA + (size_t)nxt.kh * khoff : cA; const char* nB = has_next ? (const char*)g.Bt + (size_t)nxt.pn * tstepB + (size_t)nxt.kh * khoff : cB;
        for (int t = 0; t < nt; t += 2) {
            const bool last = (t == nt - 2);
            const char* a1 = cA + (size_t)(t + 1) * kstep;
            const char* a2 = last ? nA : cA + (size_t)(t + 2) * kstep; const char* b2 = last ? nB : cB + (size_t)(t + 2) * kstep;
            const char* a3 = a2 + kstep; const char* b3 = b2 + kstep;
            if (last && has_next) S.a_ready(nxt);
            if constexpr (SP2) {
            PG8_LDB(B0, 0, 0); PG8_LDB(B1, 0, 1); PG8_SCHED; PG8_LDA(At, 0, 0); PG8_STAGE(PG8_SA(1, 1), a1 + hstepA, voffA);
            PG8_WAIT_V(8); PG8_WAIT_L(0); PG8_BAR; PG8_MMA(0, 0, At, B0); PG8_MMA(0, 1, At, B1); PG8_BAR; PG8_SCHED;
            PG8_LDA(At, 0, 1); PG8_STAGE(PG8_SB(0, 0), b2, voffB); PG8_STAGE(PG8_SB(0, 1), b2 + hstepB, voffB); PG8_STAGE(PG8_SA(0, 0), a2, voffA);
            PG8_WAIT_V(8); PG8_WAIT_L(0); PG8_BAR; PG8_MMA(1, 0, At, B0); PG8_MMA(1, 1, At, B1); PG8_BAR; PG8_SCHED;
            PG8_LDB(B0, 1, 0); PG8_LDB(B1, 1, 1); PG8_SCHED; PG8_LDA(At, 1, 0); PG8_STAGE(PG8_SA(0, 1), a2 + hstepA, voffA);
            PG8_WAIT_V(8); PG8_WAIT_L(0); PG8_BAR; PG8_MMA(0, 0, At, B0); PG8_MMA(0, 1, At, B1); PG8_BAR; PG8_SCHED;
            PG8_LDA(At, 1, 1); PG8_STAGE(PG8_SB(1, 0), b3, voffB); PG8_STAGE(PG8_SB(1, 1), b3 + hstepB, voffB); PG8_STAGE(PG8_SA(1, 0), a3, voffA);
            PG8_WAIT_V(8); PG8_WAIT_L(0); PG8_BAR; PG8_MMA(1, 0, At, B0); PG8_MMA(1, 1, At, B1); PG8_BAR; PG8_SCHED;
            } else {
            PG8_LDB(B0, 0, 0); PG8_SCHED; PG8_LDA(At, 0, 0); PG8_STAGE(PG8_SA(1, 1), a1 + hstepA, voffA);
            PG8_WAIT_L(8); PG8_BAR; PG8_WAIT_L(0); PG8_MMA(0, 0, At, B0); PG8_BAR; PG8_SCHED;
            PG8_LDB(B1, 0, 1); PG8_STAGE(PG8_SB(0, 0), b2, voffB);
            PG8_BAR; PG8_WAIT_L(0); PG8_MMA(0, 1, At, B1); PG8_BAR;
            PG8_LDA(At, 0, 1); PG8_STAGE(PG8_SA(0, 0), a2, voffA);
            PG8_BAR; PG8_WAIT_L(0); PG8_MMA(1, 0, At, B0); PG8_BAR; PG8_SCHED;
            PG8_STAGE(PG8_SB(0, 1), b2 + hstepB, voffB);
            PG8_WAIT_V(6); PG8_BAR; PG8_MMA(1, 1, At, B1); PG8_BAR;
            PG8_LDB(B0, 1, 0); PG8_SCHED; PG8_LDA(At, 1, 0); PG8_STAGE(PG8_SA(0, 1), a2 + hstepA, voffA);
            PG8_WAIT_L(8); PG8_BAR; PG8_WAIT_L(0); PG8_MMA(0, 0, At, B0); PG8_BAR; PG8_SCHED;
            PG8_LDB(B1, 1, 1); PG8_STAGE(PG8_SB(1, 0), b3, voffB);
            PG8_BAR; PG8_WAIT_L(0); PG8_MMA(0, 1, At, B1); PG8_BAR;
            PG8_LDA(At, 1, 1); PG8_STAGE(PG8_SA(1, 0), a3, voffA);
            PG8_BAR; PG8_WAIT_L(0); PG8_MMA(1, 0, At, B0); PG8_BAR; PG8_SCHED;
            PG8_STAGE(PG8_SB(1, 1), b3 + hstepB, voffB);
            PG8_WAIT_V(6); PG8_BAR; PG8_MMA(1, 1, At, B1); PG8_BAR;
            }
        }
        if constexpr (ALIGN_EPI) { if (wr == 0) PG8_BAR; }
        bool keep_acc = false;
        if constexpr (Epi::SPLIT2) keep_acc = (cur.kh == 0);
        if constexpr (!Epi::AFTER_DRAIN) { if constexpr (Epi::SPLIT2) { if (keep_acc) E.mid(acc, cur, wr, wc, fr, fq); else E(acc, cur, wr, wc, fr, fq); } else E(acc, cur, wr, wc, fr, fq); S.done(cur); }
        if (!has_next) break;
        if (!keep_acc)
#pragma unroll
        for (int a = 0; a < 2; ++a)
#pragma unroll
            for (int b = 0; b < 2; ++b)
#pragma unroll
                for (int m = 0; m < 4; ++m)
#pragma unroll
                    for (int n = 0; n < 2; ++n) acc[a][b][m][n] = (f32x4){0.f, 0.f, 0.f, 0.f};
        cur = nxt; cA = nA; cB = nB; ++ui;
        if constexpr (ALIGN_EPI) { if (wr == 1) PG8_BAR; }
    }
    PG8_WAIT_V(0);
    if constexpr (!ALIGN_EPI) { if (wr == 0) PG8_BAR; }
    PG8_BAR;
    if constexpr (Epi::AFTER_DRAIN) { E.fused(acc, cur, wr, wc, fr, fq, lds, wid, lane); S.done(cur); }
#undef PG8_SA
#undef PG8_SB
#undef PG8_STAGE
#undef PG8_LDA
#undef PG8_LDB
#undef PG8_MMA
#undef PG8_WAIT_V
#undef PG8_WAIT_L
#undef PG8_BAR
#undef PG8_SCHED
}
}

using pg8::bf16_t; using pg8::bf16x8; using pg8::f32x4; using pg8::u32x4; using pg8::Unit; using pg8::cvt_pk_bf16;
typedef unsigned u32x2 __attribute__((ext_vector_type(2)));
#define LAS __attribute__((address_space(3)))

constexpr int MP = 32768, MS = 128, MTOT = MP + MS, MPAD = 33024;
constexpr int DM = 1024, NIN = 3840, DFF = 3072, NUP = 6144;
constexpr float EPSN = 1e-6f;
constexpr float LOG2E = 1.4426950408889634f;
constexpr float QSCALE = 0.125f * LOG2E;
constexpr size_t O_Y = 0, O_KP = 33685504, O_VP = 33947648, O_GP = 34209792, O_CP = 35258368, O_KS = 35454976, O_VS = 37552128, O_GS = 39649280, O_CS = 39714816, O_END = 41287680;
constexpr size_t MiB = 1u << 20;
constexpr size_t WS_WIN = 1 * MiB, WS_WPA = 9 * MiB, WS_WPB = 10 * MiB, WS_WO = 11 * MiB, WS_WUP = 13 * MiB, WS_WDN = 25 * MiB, WS_WSB = 31 * MiB, WS_ROPE = 31 * MiB + 512 * 1024;
constexpr size_t WS_SSQ1 = 32 * MiB, WS_SSQ2 = 35 * MiB;
constexpr size_t WS_XN = 40 * MiB, WS_U = 105 * MiB, WS_AV = 138 * MiB, WS_Q = 171 * MiB, WS_KB = 204 * MiB, WS_VB = 213 * MiB, WS_SA = 222 * MiB, WS_SB = 287 * MiB;
constexpr size_t WS_Y = 352 * MiB, WS_T = 418 * MiB, WS_MG = 105 * MiB, WS_X2B = 105 * MiB, WS_X1B = 40 * MiB, WS_ACT = 222 * MiB, WS_HEAD = 418 * MiB, WS_TAIL = 443 * MiB, WS_END = 483 * MiB;
constexpr int LDS_BYTES = 147456;

struct Args { const float* in[21]; float* out; unsigned char* ws; int dbg; int pad; };

__device__ __forceinline__ float bflo(unsigned w) { return __uint_as_float(w << 16); }
__device__ __forceinline__ float bfhi(unsigned w) { return __uint_as_float(w & 0xffff0000u); }
__device__ __forceinline__ float bf2f(bf16_t h) { return __uint_as_float((unsigned)h << 16); }
__device__ __forceinline__ bf16_t f2bf(float f) { return (bf16_t)(cvt_pk_bf16(f, 0.f) & 0xffffu); }
__device__ __forceinline__ float gelu_t(float x) { const float u = x * (1.5957691216f + 0.0713548163f * x * x); const float e = __builtin_amdgcn_exp2f(-LOG2E * u); return x * __builtin_amdgcn_rcpf(1.f + e); }
__device__ __forceinline__ float sigm(float x) { return __builtin_amdgcn_rcpf(1.f + __builtin_amdgcn_exp2f(-LOG2E * x)); }
__device__ __forceinline__ u32x2 pack4(f32x4 v) { u32x2 w; w.x = cvt_pk_bf16(v[0], v[1]); w.y = cvt_pk_bf16(v[2], v[3]); return w; }
__device__ __forceinline__ f32x4 unpack4(u32x2 w) { return (f32x4){bflo(w.x), bfhi(w.x), bflo(w.y), bfhi(w.y)}; }
__device__ __forceinline__ float wave_sum(float v) {
#pragma unroll
    for (int o = 1; o < 64; o <<= 1) v += __shfl_xor(v, o);
    return v;
}
__device__ __forceinline__ float wave_max(float v) {
#pragma unroll
    for (int o = 1; o < 64; o <<= 1) v = fmaxf(v, __shfl_xor(v, o));
    return v;
}

typedef const f32x4 (&AccRef)[2][2][4][2];

struct EpiIn {
    static constexpr bool PERM = false, AFTER_DRAIN = false; static constexpr bool SPLIT2 = false;
    bf16_t *U, *AV, *Q, *KB, *VB, *SA, *SB; const float* rope; float* out;
    __device__ __forceinline__ void operator()(AccRef acc, const Unit& u, int wr, int wc, int fr, int fq) const {
        const int pn = u.pn;
        const int rbase = u.pm * 256 + wr * 64 + fr;
        const int cl = wc * 32 + 4 * fq;
        if (pn < 4) {
            bf16_t* base = pn < 2 ? U : AV; const int c0 = (pn & 1) * 256;
#pragma unroll
            for (int ai = 0; ai < 2; ++ai)
#pragma unroll
                for (int m = 0; m < 4; ++m) {
                    const int row = rbase + ai * 128 + m * 16;
                    if (row < MTOT) {
                        bf16_t* rp = base + (size_t)row * 512 + c0 + wc * 32 + 8 * fq;
#pragma unroll
                        for (int bj = 0; bj < 2; ++bj) {
                            f32x4 v0 = acc[ai][bj][m][0], v1 = acc[ai][bj][m][1];
                            v0[0] = gelu_t(v0[0]); v0[1] = gelu_t(v0[1]); v0[2] = gelu_t(v0[2]); v0[3] = gelu_t(v0[3]);
                            v1[0] = gelu_t(v1[0]); v1[1] = gelu_t(v1[1]); v1[2] = gelu_t(v1[2]); v1[3] = gelu_t(v1[3]);
                            const u32x2 lo = pack4(v0), hi = pack4(v1);
                            *(u32x4*)(rp + bj * 128) = (u32x4){lo.x, lo.y, hi.x, hi.y};
                        }
                    }
                }
        } else if (pn >= 7) {
            const int c0 = (pn - 7) * 128 + wc * 32 + 8 * fq;
#pragma unroll
            for (int ai = 0; ai < 2; ++ai)
#pragma unroll
                for (int m = 0; m < 4; ++m) {
                    const int row = rbase + ai * 128 + m * 16;
                    if (row < MTOT) {
                        u32x2 rw[2], sw[2];
#pragma unroll
                        for (int n = 0; n < 2; ++n) {
                            const f32x4 ga = acc[ai][0][m][n], gb = acc[ai][1][m][n];
                            f32x4 r, sb;
#pragma unroll
                            for (int j = 0; j < 4; ++j) {
                                const float ea = __builtin_amdgcn_exp2f(-LOG2E * ga[j]), eb = __builtin_amdgcn_exp2f(-LOG2E * gb[j]);
                                sb[j] = __builtin_amdgcn_rcpf(1.f + eb); r[j] = (1.f + eb) * __builtin_amdgcn_rcpf(1.f + ea);
                            }
                            rw[n] = pack4(r); sw[n] = pack4(sb);
                        }
                        const size_t off = (size_t)row * 1024 + c0;
                        *(u32x4*)(SA + off) = (u32x4){rw[0].x, rw[0].y, rw[1].x, rw[1].y}; *(u32x4*)(SB + off) = (u32x4){sw[0].x, sw[0].y, sw[1].x, sw[1].y};
                    }
                }
        } else {
            const int g = wc & 1, i0 = g * 16 + 4 * fq;
#pragma unroll
            for (int ai = 0; ai < 2; ++ai) {
                f32x4 rc0[4], rc1[4];
#pragma unroll
                for (int m = 0; m < 4; ++m) { const int row_ = rbase + ai * 128 + m * 16; const int pidx_ = row_ >= MP ? 2048 : (row_ & 2047);
                    const f32x4* rp_ = (const f32x4*)(rope + ((size_t)pidx_ * 32 + i0) * 2); rc0[m] = rp_[0]; rc1[m] = rp_[1]; }
#pragma unroll
                for (int m = 0; m < 4; ++m) {
                    const int row = rbase + ai * 128 + m * 16;
                    if (row < MTOT) {
                        const bool smp = row >= MP;
                        const f32x4 cs0 = rc0[m], cs1 = rc1[m];
                        const f32x4 cc = (f32x4){cs0[0], cs0[2], cs1[0], cs1[2]}, ss = (f32x4){cs0[1], cs0[3], cs1[1], cs1[3]};
                        const int s = row & 2047, bb = row >> 11;
#pragma unroll
                        for (int bj = 0; bj < 2; ++bj) {
                            if (pn == 6 && bj == 1) {
#pragma unroll
                                for (int n = 0; n < 2; ++n) {
                                    const int col = wc * 32 + 8 * fq + 4 * n;
                                    const f32x4 v = acc[ai][1][m][n];
                                    *(u32x2*)(VB + (size_t)row * 128 + col) = pack4(v);
                                    if (smp) *(f32x4*)(out + O_VS + ((size_t)(row - MP) * 128 + 127) * 128 + col) = v;
                                    else if (s >= 1920) *(f32x4*)(out + O_VP + ((size_t)bb * 128 + (s - 1920)) * 128 + col) = v;
                                }
                            } else {
                                const f32x4 x1 = acc[ai][bj][m][0], x2 = acc[ai][bj][m][1];
                                f32x4 o1 = x1 * cc - x2 * ss, o2 = x2 * cc + x1 * ss;
                                if (pn < 6) {
                                    const int ht = 2 * bj + (wc >> 1);
                                    o1 = o1 * QSCALE; o2 = o2 * QSCALE;
                                    bf16_t* qp = Q + (size_t)row * 512 + (pn - 4) * 256 + ht * 64 + i0;
                                    *(u32x2*)qp = pack4(o1); *(u32x2*)(qp + 32) = pack4(o2);
                                } else {
                                    const int hd = wc >> 1;
                                    bf16_t* kp = KB + (size_t)row * 128 + hd * 64 + i0;
                                    *(u32x2*)kp = pack4(o1); *(u32x2*)(kp + 32) = pack4(o2);
                                    if (smp) { float* op = out + O_KS + ((size_t)(row - MP) * 128 + 127) * 128 + hd * 64 + i0; *(f32x4*)op = o1; *(f32x4*)(op + 32) = o2; }
                                    else if (s >= 1920) { float* op = out + O_KP + ((size_t)bb * 128 + (s - 1920)) * 128 + hd * 64 + i0; *(f32x4*)op = o1; *(f32x4*)(op + 32) = o2; }
                                }
                            }
                        }
                    }
                }
            }
        }
    }
};

struct EpiGate {
    static constexpr bool PERM = true, AFTER_DRAIN = false; static constexpr bool SPLIT2 = true;
    const bf16_t* SA; const bf16_t* SB; bf16_t* MG;
    __device__ __forceinline__ void mid(f32x4 (&acc)[2][2][4][2], const Unit& u, int wr, int wc, int fr, int fq) const {
        const int rbase = u.pm * 256 + wr * 64 + fr, c0 = u.pn * 256 + wc * 32 + 8 * fq;
#pragma unroll
        for (int ai = 0; ai < 2; ++ai)
#pragma unroll
            for (int m = 0; m < 4; ++m) {
                const int row = rbase + ai * 128 + m * 16;
#pragma unroll
                for (int bj = 0; bj < 2; ++bj) {
                    const u32x4 w = *(const u32x4*)(SA + (size_t)row * 1024 + c0 + bj * 128);
                    acc[ai][bj][m][0] = acc[ai][bj][m][0] * unpack4((u32x2){w.x, w.y});
                    acc[ai][bj][m][1] = acc[ai][bj][m][1] * unpack4((u32x2){w.z, w.w});
                }
            }
    }
    __device__ __forceinline__ void operator()(AccRef acc, const Unit& u, int wr, int wc, int fr, int fq) const {
        const int rbase = u.pm * 256 + wr * 64 + fr, c0 = u.pn * 256 + wc * 32 + 8 * fq;
#pragma unroll
        for (int ai = 0; ai < 2; ++ai) {
            u32x4 sbw[4][2];
#pragma unroll
            for (int m = 0; m < 4; ++m)
#pragma unroll
                for (int bj = 0; bj < 2; ++bj) sbw[m][bj] = *(const u32x4*)(SB + (size_t)(rbase + ai * 128 + m * 16) * 1024 + c0 + bj * 128);
#pragma unroll
            for (int m = 0; m < 4; ++m) {
                const int row = rbase + ai * 128 + m * 16;
#pragma unroll
                for (int bj = 0; bj < 2; ++bj) {
                    const u32x2 lo = pack4(unpack4((u32x2){sbw[m][bj].x, sbw[m][bj].y}) * acc[ai][bj][m][0]), hi = pack4(unpack4((u32x2){sbw[m][bj].z, sbw[m][bj].w}) * acc[ai][bj][m][1]);
                    *(u32x4*)(MG + (size_t)row * 1024 + c0 + bj * 128) = (u32x4){lo.x, lo.y, hi.x, hi.y};
                }
            }
        }
    }
};
struct EpiRes {
    static constexpr bool PERM = true, AFTER_DRAIN = false; static constexpr bool SPLIT2 = false;
    const float* xp; const bf16_t* xbin; bf16_t* XB; float* ssq;
    __device__ __forceinline__ void operator()(AccRef acc, const Unit& u, int wr, int wc, int fr, int fq) const {
        const int rbase = u.pm * 256 + wr * 64 + fr, c0 = u.pn * 256 + wc * 32 + 8 * fq;
#pragma unroll
        for (int ai = 0; ai < 2; ++ai) {
            f32x4 bs[4][2][2];
            if (xbin) {
#pragma unroll
                for (int m = 0; m < 4; ++m)
#pragma unroll
                    for (int bj = 0; bj < 2; ++bj) { const u32x4 w = *(const u32x4*)(xbin + (size_t)(rbase + ai * 128 + m * 16) * 1024 + c0 + bj * 128);
                        bs[m][bj][0] = unpack4((u32x2){w.x, w.y}); bs[m][bj][1] = unpack4((u32x2){w.z, w.w}); }
            } else {
#pragma unroll
                for (int m = 0; m < 4; ++m)
#pragma unroll
                    for (int bj = 0; bj < 2; ++bj)
#pragma unroll
                        for (int n = 0; n < 2; ++n) bs[m][bj][n] = __builtin_nontemporal_load((const f32x4*)(xp + (size_t)(rbase + ai * 128 + m * 16) * 1024 + c0 + bj * 128 + n * 4));
            }
#pragma unroll
            for (int m = 0; m < 4; ++m) {
                const int row = rbase + ai * 128 + m * 16;
                float q = 0.f;
#pragma unroll
                for (int bj = 0; bj < 2; ++bj) {
                    const f32x4 v0 = bs[m][bj][0] + acc[ai][bj][m][0], v1 = bs[m][bj][1] + acc[ai][bj][m][1];
                    const u32x2 lo = pack4(v0), hi = pack4(v1);
                    *(u32x4*)(XB + (size_t)row * 1024 + c0 + bj * 128) = (u32x4){lo.x, lo.y, hi.x, hi.y};
                    q += ((v0[0] * v0[0] + v0[1] * v0[1]) + (v0[2] * v0[2] + v0[3] * v0[3])) + ((v1[0] * v1[0] + v1[1] * v1[1]) + (v1[2] * v1[2] + v1[3] * v1[3]));
                }
                q += __shfl_xor(q, 16); q += __shfl_xor(q, 32);
                if (fq == 0) ssq[(size_t)row * 16 + u.pn * 4 + wc] = q;
            }
        }
    }
};
#ifndef USE_DPP
#define USE_DPP 1
#endif
__device__ __forceinline__ float rot_prev(float x, int srcl, int ctrl_is_2) {
#if USE_DPP
    return ctrl_is_2 ? __uint_as_float(__builtin_amdgcn_update_dpp(0, __float_as_uint(x), 0x122, 0xf, 0xf, false)) : __uint_as_float(__builtin_amdgcn_update_dpp(0, __float_as_uint(x), 0x121, 0xf, 0xf, false));
#else
    return __shfl(x, srcl, 16);
#endif
}
struct EpiUp {
    static constexpr bool PERM = false, AFTER_DRAIN = false; static constexpr bool SPLIT2 = false;
    const float* ssq1; const float* cw; const float* cb; bf16_t* ACT; float* HEAD; float* TAIL; float* out; LAS float* wlds;
    __device__ __forceinline__ void operator()(AccRef acc, const Unit& u, int wr, int wc, int fr, int fq) const {
        const int pn = u.pn, pm = u.pm;
        const int colA = pn * 128 + wc * 32 + 4 * fq;
        const int lane15m1 = (fr + 15) & 15, lane15m2 = (fr + 14) & 15;
        LAS float* wl = wlds + (wr * 4 + wc) * 256;
        float rstdv[2][4];
        {
            f32x4 sv[2][4];
#pragma unroll
            for (int ai = 0; ai < 2; ++ai)
#pragma unroll
                for (int m = 0; m < 4; ++m) sv[ai][m] = *(const f32x4*)(ssq1 + (size_t)(pm * 256 + ai * 128 + wr * 64 + m * 16 + fr) * 16 + 4 * fq);
#pragma unroll
            for (int ai = 0; ai < 2; ++ai)
#pragma unroll
                for (int m = 0; m < 4; ++m) { float sq = (sv[ai][m][0] + sv[ai][m][1]) + (sv[ai][m][2] + sv[ai][m][3]); sq += __shfl_xor(sq, 16); sq += __shfl_xor(sq, 32); rstdv[ai][m] = rsqrtf(sq * (1.f / 1024.f) + EPSN); }
        }
        {
            const int g = fq * 16 + fr, kind = g >> 4, bjj = (g >> 3) & 1, c4 = (g & 7) * 4;
            const float* src = (kind < 3 ? cw + kind * 6144 : cb) + bjj * 3072 + pn * 128 + wc * 32 + c4;
            *(LAS f32x4*)(wl + g * 4) = *(const f32x4*)src;
        }
#pragma unroll
        for (int ai = 0; ai < 2; ++ai) {
            const int rowb = pm * 256 + ai * 128 + wr * 64;
            const int blk = rowb >> 6;
            f32x4 pv[2][2];
#pragma unroll
            for (int bj = 0; bj < 2; ++bj)
#pragma unroll
                for (int n = 0; n < 2; ++n) pv[bj][n] = (f32x4){0.f, 0.f, 0.f, 0.f};
#pragma unroll
            for (int m = 0; m < 4; ++m) {
                const int row = rowb + m * 16 + fr;
                const float rstd = rstdv[ai][m];
                const int s = row & 2047;
#pragma unroll
                for (int n = 0; n < 2; ++n) {
                    f32x4 cc[2];
#pragma unroll
                    for (int bj = 0; bj < 2; ++bj) {
                        const int ac = bj * 3072 + colA + 16 * n;
                        const f32x4 v = acc[ai][bj][m][n] * rstd;
                        if (m == 0 && fr < 2) *(f32x4*)(HEAD + ((size_t)blk * 2 + fr) * 6144 + ac) = v;
                        if (m == 3 && fr >= 14) *(f32x4*)(TAIL + ((size_t)blk * 2 + (fr - 14)) * 6144 + ac) = v;
                        if (m == 3 && ai == 1 && wr == 1 && (pm & 7) == 7 && s >= 2046) *(f32x4*)(out + O_CP + ((size_t)(row >> 11) * 2 + (s - 2046)) * 6144 + ac) = v;
                        const LAS float* wp = wl + bj * 32 + 16 * n + 4 * fq;
                        const f32x4 w0 = *(const LAS f32x4*)(wp), w1 = *(const LAS f32x4*)(wp + 64), w2 = *(const LAS f32x4*)(wp + 128), b0 = *(const LAS f32x4*)(wp + 192);
                        f32x4 v1, v2;
#pragma unroll
                        for (int j = 0; j < 4; ++j) {
                            const float cur = v[j], prv = pv[bj][n][j];
                            const float sel1 = (fr == 15) ? prv : cur, sel2 = (fr >= 14) ? prv : cur;
                            v1[j] = rot_prev(sel1, lane15m1, 0); v2[j] = rot_prev(sel2, lane15m2, 1);
                        }
                        cc[bj] = b0 + w0 * v2 + w1 * v1 + w2 * v;
                        pv[bj][n] = v;
                    }
                    f32x4 a;
#pragma unroll
                    for (int j = 0; j < 4; ++j) a[j] = gelu_t(cc[0][j]) * cc[1][j];
                    if (m > 0 || fr >= 2) *(u32x2*)(ACT + (size_t)row * 3072 + colA + 16 * n) = pack4(a);
                }
            }
        }
    }
};

__device__ __forceinline__ unsigned f2bf_sw(float f) { unsigned u = __float_as_uint(f); return (u + 0x7fffu + ((u >> 16) & 1u)) >> 16; }
__device__ __forceinline__ unsigned pk2(float lo, float hi) { return f2bf_sw(lo) | (f2bf_sw(hi) << 16); }
__device__ __forceinline__ int perm32c(int w) { return 8 * ((w >> 2) & 3) + 4 * (w >> 4) + (w & 3); }
__device__ __forceinline__ int map_in(int p) {
    if (p >= 1792) { const int t = (p - 1792) >> 8, q = (p - 1792) & 255; return 1792 + (q >> 7) * 1024 + t * 128 + (q & 96) + perm32c(q & 31); }
    if (p < 1024 || p >= 1664) return (p & ~31) + perm32c(p & 31);
    const int h64 = p & ~63, g = (p & 63) >> 5, w = p & 31;
    return h64 + (w >> 4) * 32 + g * 16 + (w & 15);
}
__device__ __forceinline__ int map_up(int p) { const int pn = p >> 8, q = p & 255; return (q >> 7) * 3072 + pn * 128 + (q & 127); }
template <int MAPID>
__device__ __forceinline__ void p0_transpose_item(const float* W, int K, int N, bf16_t* WT, const float* kscale, LAS float* scr, int item, int lane, int ldk = 0, int koff = 0) {
    if (ldk == 0) ldk = K;
    const int nblk = N / 32, kb = item / nblk, nb = item % nblk, k0 = 64 * kb, n0 = 32 * nb;
    const int p = n0 + (lane & 31);
    const int src = MAPID == 1 ? map_in(p) : (MAPID == 2 ? map_up(p) : p);
    float wv[32];
#pragma unroll
    for (int i = 0; i < 32; ++i) { const int kk = 2 * i + (lane >> 5); wv[i] = __builtin_nontemporal_load(W + (size_t)(k0 + kk) * N + src); }
    if (kscale) {
#pragma unroll
        for (int i = 0; i < 32; ++i) wv[i] *= kscale[k0 + 2 * i + (lane >> 5)];
    }
#pragma unroll
    for (int i = 0; i < 32; ++i) scr[(2 * i + (lane >> 5)) * 33 + (lane & 31)] = wv[i];
    asm volatile("s_waitcnt lgkmcnt(0)" ::: "memory");
    const int c = lane & 7;
#pragma unroll
    for (int j = 0; j < 4; ++j) { const int n = (lane >> 3) + 8 * j; const LAS float* s = scr + (8 * c) * 33 + n;
        u32x4 o; o.x = pk2(s[0 * 33], s[1 * 33]); o.y = pk2(s[2 * 33], s[3 * 33]); o.z = pk2(s[4 * 33], s[5 * 33]); o.w = pk2(s[6 * 33], s[7 * 33]);
        *(u32x4*)(WT + (size_t)(n0 + n) * ldk + koff + k0 + 8 * c) = o; }
    asm volatile("s_waitcnt lgkmcnt(0)" ::: "memory");
}

__device__ __forceinline__ void p0_prologue(const Args& a, LAS unsigned char* lds, int part, int wk, int nwk) {
    const int tid = threadIdx.x, lane = tid & 63, wave = __builtin_amdgcn_readfirstlane(tid >> 6);
    unsigned char* ws = a.ws;
    LAS float* scr = (LAS float*)(lds + wave * 16384);
    const int gw = wk * 8 + wave, NGW = nwk * 8;
    const long gt = (long)wk * 512 + tid, NT = (long)nwk * 512;
    constexpr int I_IN = 16 * 120, I_PA = 8 * 32, I_PB = 8 * 32, I_O = 16 * 32, I_UP = 16 * 192, I_DN = 48 * 32;
    constexpr int NITEMS = I_IN + I_PA + I_PB + I_O + I_UP + I_DN;
    if (part == 1)
    for (int it = I_IN + gw; it < NITEMS; it += NGW) {
        int r = it;
        if (r < I_IN) { p0_transpose_item<1>(a.in[6], 1024, NIN, (bf16_t*)(ws + WS_WIN), nullptr, scr, r, lane); continue; } r -= I_IN;
        if (r < I_PA) { p0_transpose_item<0>(a.in[12], 512, 1024, (bf16_t*)(ws + WS_WPA), nullptr, scr, r, lane, 1024, 0); continue; } r -= I_PA;
        if (r < I_PB) { p0_transpose_item<0>(a.in[13], 512, 1024, (bf16_t*)(ws + WS_WPA), nullptr, scr, r, lane, 1024, 512); continue; } r -= I_PB;
        if (r < I_O) { p0_transpose_item<0>(a.in[14], 1024, 1024, (bf16_t*)(ws + WS_WO), nullptr, scr, r, lane); continue; } r -= I_O;
        if (r < I_UP) { p0_transpose_item<2>(a.in[16], 1024, NUP, (bf16_t*)(ws + WS_WUP), a.in[15], scr, r, lane); continue; } r -= I_UP;
        p0_transpose_item<0>(a.in[19], 3072, 1024, (bf16_t*)(ws + WS_WDN), nullptr, scr, r, lane);
    }
    if (part == 0) {
        bf16_t* XN = (bf16_t*)(ws + WS_XN); const float* g = a.in[5];
        f32x4 gg[4];
#pragma unroll
        for (int j = 0; j < 4; ++j) gg[j] = ((const f32x4*)g)[64 * j + lane];
        for (int ch = gw; ch < MPAD / 8; ch += NGW) {
            const int rowc = ch * 8;
            if (rowc >= MTOT) {
#pragma unroll
                for (int r = 0; r < 8; ++r) { unsigned long long* o8 = (unsigned long long*)(XN + (size_t)(rowc + r) * 1024) + lane;
#pragma unroll
                    for (int j = 0; j < 4; ++j) o8[64 * j] = 0ull; }
                continue;
            }
            const float* xr = rowc < MP ? a.in[0] + (size_t)rowc * 1024 : a.in[1] + (size_t)(rowc - MP) * 1024;
            f32x4 v[8][4];
#pragma unroll
            for (int r = 0; r < 8; ++r)
#pragma unroll
                for (int j = 0; j < 4; ++j) v[r][j] = __builtin_nontemporal_load(((const f32x4*)(xr + (size_t)r * 1024)) + 64 * j + lane);
#pragma unroll
            for (int r = 0; r < 8; ++r) {
                float s = 0.f;
#pragma unroll
                for (int j = 0; j < 4; ++j) s += (v[r][j][0] * v[r][j][0] + v[r][j][1] * v[r][j][1]) + (v[r][j][2] * v[r][j][2] + v[r][j][3] * v[r][j][3]);
                const float rstd = rsqrtf(wave_sum(s) * (1.f / 1024.f) + EPSN);
                unsigned long long* o8 = (unsigned long long*)(XN + (size_t)(rowc + r) * 1024) + lane;
#pragma unroll
                for (int j = 0; j < 4; ++j) { const f32x4 y = v[r][j] * rstd * gg[j];
                    o8[64 * j] = (unsigned long long)cvt_pk_bf16(y[0], y[1]) | ((unsigned long long)cvt_pk_bf16(y[2], y[3]) << 32); }
            }
        }
    }
    if (part == 0)
    for (int it = gw; it < I_IN; it += NGW) p0_transpose_item<1>(a.in[6], 1024, NIN, (bf16_t*)(ws + WS_WIN), nullptr, scr, it, lane);
    if (part == 0) {
        float* rope = (float*)(ws + WS_ROPE);
        for (long e = gt; e < 2049 * 32; e += NT) {
            const int pi = (int)(e >> 5), i = (int)(e & 31);
            const double pos = pi == 2048 ? 16384.0 : (double)pi;
            double inv = 1.0; for (int k = 0; k < i; ++k) inv *= 0.74989420933245582730;
            double turns = pos * inv * 0.15915494309189533577;
            turns -= __builtin_floor(turns);
            const float tf = (float)turns;
            rope[e * 2] = __builtin_amdgcn_cosf(tf); rope[e * 2 + 1] = __builtin_amdgcn_sinf(tf);
        }
    }
    if (part == 1) {
        bf16_t* WSB = (bf16_t*)(ws + WS_WSB); const float* w_s = a.in[9];
        for (long e = gt; e < 8 * 128 * 128; e += NT) { const int t = (int)(e >> 7) & 127, s = (int)e & 127; WSB[e] = (s <= t) ? (bf16_t)f2bf_sw(w_s[e]) : (bf16_t)0; }
    }
    if (part == 1) {
        const f32x4* ck = (const f32x4*)a.in[2]; const f32x4* cv = (const f32x4*)a.in[3];
        f32x4* ok = (f32x4*)(a.out + O_KS); f32x4* ov = (f32x4*)(a.out + O_VS);
        for (long e0 = gt; e0 < 128L * 127 * 32; e0 += 4 * NT) {
            f32x4 tk[4], tv[4]; long di[4];
#pragma unroll
            for (int q = 0; q < 4; ++q) { const long e = e0 + q * NT; const bool ok_ = e < 128L * 127 * 32; const long ee = ok_ ? e : 0; const long b = ee / (127 * 32), r = ee % (127 * 32); const long j = r >> 5, x = r & 31;
                di[q] = ok_ ? (b * 128 + j) * 32 + x : -1; tk[q] = __builtin_nontemporal_load(ck + (b * 128 + j + 1) * 32 + x); tv[q] = __builtin_nontemporal_load(cv + (b * 128 + j + 1) * 32 + x); }
#pragma unroll
            for (int q = 0; q < 4; ++q) if (di[q] >= 0) { __builtin_nontemporal_store(tk[q], ok + di[q]); __builtin_nontemporal_store(tv[q], ov + di[q]); }
        }
        const f32x4* st = (const f32x4*)a.in[4]; f32x4* oc = (f32x4*)(a.out + O_CS);
        for (long e = gt; e < 128L * 1536; e += NT) { const long b = e / 1536, x = e % 1536; oc[(b * 2 + 0) * 1536 + x] = st[(b * 2 + 1) * 1536 + x]; }
    }
}

__device__ __forceinline__ f32x4 mfma16(bf16x8 a, bf16x8 b, f32x4 c) { return __builtin_amdgcn_mfma_f32_16x16x32_bf16(a, b, c, 0, 0, 0); }

__device__ __forceinline__ void mixer_prompt_unit(const Args& a, unsigned char* lds, int b, int c) {
    unsigned char* ws = a.ws;
    const bf16_t* __restrict__ U = (const bf16_t*)(ws + WS_U); const bf16_t* __restrict__ AV = (const bf16_t*)(ws + WS_AV); const bf16_t* __restrict__ Q = (const bf16_t*)(ws + WS_Q);
    const bf16_t* __restrict__ KB = (const bf16_t*)(ws + WS_KB); const bf16_t* __restrict__ VB = (const bf16_t*)(ws + WS_VB); const bf16_t* __restrict__ WSB = (const bf16_t*)(ws + WS_WSB);
    bf16_t* __restrict__ YA = (bf16_t*)(ws + WS_Y); bf16_t* __restrict__ YB = (bf16_t*)(ws + WS_Y) + 512;
    const int tid = threadIdx.x, lane = tid & 63, w = __builtin_amdgcn_readfirstlane(tid >> 6), l15 = lane & 15, lg = lane >> 4;
    const int r0 = b * 2048 + c * 128;
    float2* MU = (float2*)lds;
    u32x4 vst[8];
#pragma unroll
    for (int it = 0; it < 8; ++it) { const int idx = it * 512 + tid, key = idx >> 4, ch = idx & 15; int kr = r0 - 128 + key; if (c == 0 && key < 128) kr = r0 + key;
        vst[it] = *(const u32x4*)(VB + (size_t)kr * 128 + ch * 8); }
    __syncthreads();
    {
        const int row = tid >> 2, part = tid & 3;
        const u32x4* src = (const u32x4*)(AV + (size_t)(r0 + row) * 512 + part * 128);
        u32x4 v[16]; float s = 0.f;
#pragma unroll
        for (int i = 0; i < 16; ++i) v[i] = src[i];
#pragma unroll
        for (int i = 0; i < 16; ++i)
#pragma unroll
            for (int k = 0; k < 4; ++k) s += bflo(v[i][k]) + bfhi(v[i][k]);
        s += __shfl_xor(s, 1); s += __shfl_xor(s, 2);
        const float mean = s * (1.f / 512.f); float q = 0.f;
#pragma unroll
        for (int i = 0; i < 16; ++i)
#pragma unroll
            for (int k = 0; k < 4; ++k) { const float d0 = bflo(v[i][k]) - mean, d1 = bfhi(v[i][k]) - mean; q += d0 * d0 + d1 * d1; }
        q += __shfl_xor(q, 1); q += __shfl_xor(q, 2);
        if (part == 0) MU[row] = make_float2(mean, rsqrtf(q * (1.f / 512.f) + EPSN));
    }
    __syncthreads();
    {
        const int h = w;
        bf16_t* VT = (bf16_t*)(lds + 1024) + h * (64 * 136);
        u32x4 Uv[8][2];
#pragma unroll
        for (int tt = 0; tt < 8; ++tt)
#pragma unroll
            for (int pr = 0; pr < 2; ++pr) Uv[tt][pr] = *(const u32x4*)(U + (size_t)(r0 + 16 * tt + l15) * 512 + h * 64 + 32 * pr + 8 * lg);
        const int ch = lane & 7;
        const f32x4 g0 = *(const f32x4*)(a.in[7] + h * 64 + ch * 8), g1 = *(const f32x4*)(a.in[7] + h * 64 + ch * 8 + 4);
        const f32x4 b0 = *(const f32x4*)(a.in[8] + h * 64 + ch * 8), b1 = *(const f32x4*)(a.in[8] + h * 64 + ch * 8 + 4);
#pragma unroll 4
        for (int it = 0; it < 16; ++it) {
            const int s = it * 8 + (lane >> 3);
            const u32x4 av = *(const u32x4*)(AV + (size_t)(r0 + s) * 512 + h * 64 + ch * 8);
            const float2 ms = MU[s];
            f32x4 x0 = (f32x4){bflo(av[0]), bfhi(av[0]), bflo(av[1]), bfhi(av[1])}, x1 = (f32x4){bflo(av[2]), bfhi(av[2]), bflo(av[3]), bfhi(av[3])};
            x0 = (x0 - ms.x) * ms.y * g0 + b0; x1 = (x1 - ms.x) * ms.y * g1 + b1;
            bf16_t* vp = VT + (ch * 8) * 136 + s;
#pragma unroll
            for (int i = 0; i < 4; ++i) { vp[i * 136] = f2bf(x0[i]); vp[(i + 4) * 136] = f2bf(x1[i]); }
            if (c == 15) { float* op = a.out + O_GP + (((size_t)b * 128 + s) * 8 + h) * 64 + ch * 8; *(f32x4*)op = x0; *(f32x4*)(op + 4) = x1; }
        }
        __syncthreads();
        const bf16_t* wsb = WSB + (size_t)h * 128 * 128;
        const float* bsh = a.in[10] + h * 128;
#pragma unroll
        for (int tt = 0; tt < 8; ++tt) {
            f32x4 acc[4];
#pragma unroll
            for (int dt = 0; dt < 4; ++dt) acc[dt] = (f32x4){0.f, 0.f, 0.f, 0.f};
            const int nks = (tt >> 1) + 1;
#pragma unroll
            for (int ks = 0; ks < nks; ++ks) {
                const bf16x8 Bf = *(const bf16x8*)(wsb + (16 * tt + l15) * 128 + 32 * ks + 8 * lg);
#pragma unroll
                for (int dt = 0; dt < 4; ++dt) { const bf16x8 Af = *(const bf16x8*)(VT + (32 * (dt >> 1) + 8 * (l15 >> 2) + 4 * (dt & 1) + (l15 & 3)) * 136 + 32 * ks + 8 * lg); acc[dt] = mfma16(Af, Bf, acc[dt]); }
            }
            const int t = 16 * tt + l15; const float bs = bsh[t];
#pragma unroll
            for (int pr = 0; pr < 2; ++pr) {
                const u32x4 uw = Uv[tt][pr];
                const u32x2 lo = pack4(unpack4((u32x2){uw.x, uw.y}) * (acc[2 * pr] + bs)), hi = pack4(unpack4((u32x2){uw.z, uw.w}) * (acc[2 * pr + 1] + bs));
                *(u32x4*)(YA + (size_t)(r0 + t) * 1024 + h * 64 + 32 * pr + 8 * lg) = (u32x4){lo.x, lo.y, hi.x, hi.y};
            }
        }
    }
    __syncthreads();
    const int qhalf = w & 1;
    bf16x8 Kf[10][2], Qf[2];
#define ATT_LOAD(step) do { const int kvh_ = (step) >> 2, qt_ = (step) & 3; const int i0_ = 64 * qhalf + 16 * qt_; const int kt0_ = (i0_ >> 4) < 6 ? (i0_ >> 4) : 6; \
            const bf16_t* qp_ = Q + (size_t)(r0 + i0_ + l15) * 512 + (kvh_ * 4 + (w >> 1)) * 64 + 8 * lg; Qf[0] = *(const bf16x8*)qp_; Qf[1] = *(const bf16x8*)(qp_ + 32); \
            _Pragma("unroll") for (int j = 0; j < 10; ++j) { const int key_ = 16 * (kt0_ + j) + l15; int kr_ = r0 - 128 + key_; if (c == 0 && key_ < 128) kr_ = r0 + key_; \
                const bf16_t* kp_ = KB + (size_t)kr_ * 128 + kvh_ * 64 + 8 * lg; Kf[j][0] = *(const bf16x8*)kp_; Kf[j][1] = *(const bf16x8*)(kp_ + 32); } } while (0)
    ATT_LOAD(0);
    bf16_t* VTa = (bf16_t*)(lds + 1024);
    {
#pragma unroll
        for (int it = 0; it < 8; ++it) {
            const int idx = it * 512 + tid, key = idx >> 4, ch = idx & 15;
            const u32x4 v = vst[it];
            bf16_t* vp = VTa + (size_t)(ch * 8) * 264 + key;
#pragma unroll
            for (int i = 0; i < 4; ++i) { vp[(2 * i) * 264] = (bf16_t)(v[i] & 0xffffu); vp[(2 * i + 1) * 264] = (bf16_t)(v[i] >> 16); }
        }
    }
    __syncthreads();
    {
        for (int step = 0; step < 8; ++step) {
            const int kvh = step >> 2, qt = step & 3, qh = kvh * 4 + (w >> 1);
            const float sink2 = a.in[11][qh] * LOG2E;
            const int i0 = 64 * qhalf + 16 * qt; const int kt0 = (i0 >> 4) < 6 ? (i0 >> 4) : 6;
            f32x4 S[10];
#pragma unroll
            for (int j = 0; j < 10; ++j) { f32x4 sacc = (f32x4){0.f, 0.f, 0.f, 0.f}; sacc = mfma16(Kf[j][0], Qf[0], sacc); sacc = mfma16(Kf[j][1], Qf[1], sacc); S[j] = sacc; }
            if (step < 7) ATT_LOAD(step + 1);
            const int qi = i0 + l15;
            float mx = -INFINITY;
#pragma unroll
            for (int j = 0; j < 10; ++j)
#pragma unroll
                for (int r = 0; r < 4; ++r) {
                    const int kf = 16 * (kt0 + j) + 4 * lg + r;
                    const bool valid = (kf >= qi) && (kf <= qi + 128) && (c > 0 || kf >= 128);
                    const float sv = valid ? S[j][r] : -INFINITY;
                    S[j][r] = sv; mx = fmaxf(mx, sv);
                }
            mx = fmaxf(mx, __shfl_xor(mx, 16)); mx = fmaxf(mx, __shfl_xor(mx, 32));
            mx = fmaxf(mx, sink2);
            float sum = 0.f;
#pragma unroll
            for (int j = 0; j < 10; ++j)
#pragma unroll
                for (int r = 0; r < 4; ++r) { const float pe = __builtin_amdgcn_exp2f(S[j][r] - mx); S[j][r] = pe; sum += pe; }
            sum += __shfl_xor(sum, 16); sum += __shfl_xor(sum, 32);
            const float inv = 1.f / (sum + __builtin_amdgcn_exp2f(sink2 - mx));
            f32x4 O[4];
#pragma unroll
            for (int dt = 0; dt < 4; ++dt) O[dt] = (f32x4){0.f, 0.f, 0.f, 0.f};
#pragma unroll
            for (int kp2 = 0; kp2 < 5; ++kp2) {
                u32x4 pw; pw.x = cvt_pk_bf16(S[2 * kp2][0], S[2 * kp2][1]); pw.y = cvt_pk_bf16(S[2 * kp2][2], S[2 * kp2][3]);
                pw.z = cvt_pk_bf16(S[2 * kp2 + 1][0], S[2 * kp2 + 1][1]); pw.w = cvt_pk_bf16(S[2 * kp2 + 1][2], S[2 * kp2 + 1][3]);
                const bf16x8 Bp = __builtin_bit_cast(bf16x8, pw);
#pragma unroll
                for (int dt = 0; dt < 4; ++dt) {
                    const bf16_t* vp = VTa + (size_t)(kvh * 64 + 32 * (dt >> 1) + 8 * (l15 >> 2) + 4 * (dt & 1) + (l15 & 3)) * 264 + 16 * (kt0 + 2 * kp2) + 4 * lg;
                    const u32x2 lo = *(const u32x2*)vp, hi = *(const u32x2*)(vp + 16);
                    const u32x4 aw = (u32x4){lo.x, lo.y, hi.x, hi.y};
                    O[dt] = mfma16(__builtin_bit_cast(bf16x8, aw), Bp, O[dt]);
                }
            }
#pragma unroll
            for (int pr = 0; pr < 2; ++pr) { const u32x2 lo = pack4(O[2 * pr] * inv), hi = pack4(O[2 * pr + 1] * inv);
                *(u32x4*)(YB + (size_t)(r0 + qi) * 1024 + qh * 64 + 32 * pr + 8 * lg) = (u32x4){lo.x, lo.y, hi.x, hi.y}; }
        }
#undef ATT_LOAD
    }
    __syncthreads();
}

__device__ __forceinline__ void mixer_sample_token(const Args& a, unsigned char* lds, int bs) {
    unsigned char* ws = a.ws;
    const bf16_t* U = (const bf16_t*)(ws + WS_U); const bf16_t* AV = (const bf16_t*)(ws + WS_AV); const bf16_t* Q = (const bf16_t*)(ws + WS_Q);
    const bf16_t* KB = (const bf16_t*)(ws + WS_KB); const bf16_t* VB = (const bf16_t*)(ws + WS_VB);
    bf16_t* YA = (bf16_t*)(ws + WS_Y); bf16_t* YB = YA + 512;
    const int tid = threadIdx.x, lane = tid & 63, w = __builtin_amdgcn_readfirstlane(tid >> 6);
    const size_t row = (size_t)MP + bs;
    __syncthreads();
    {
        const u32x4 av = *(const u32x4*)(AV + row * 512 + lane * 8);
        float x[8] = {bflo(av[0]), bfhi(av[0]), bflo(av[1]), bfhi(av[1]), bflo(av[2]), bfhi(av[2]), bflo(av[3]), bfhi(av[3])};
        float s = 0.f;
#pragma unroll
        for (int i = 0; i < 8; ++i) s += x[i];
        const float mean = wave_sum(s) * (1.f / 512.f); float q = 0.f;
#pragma unroll
        for (int i = 0; i < 8; ++i) { const float d = x[i] - mean; q += d * d; }
        const float rstd = rsqrtf(wave_sum(q) * (1.f / 512.f) + EPSN);
        const int h = w, col = h * 64 + lane;
        const float xv = bf2f(AV[row * 512 + col]);
        const float vg = (xv - mean) * rstd * a.in[7][col] + a.in[8][col];
        a.out[O_GS + (size_t)bs * 512 + col] = vg;
        const float mix = a.in[9][(size_t)h * 128 * 128] * vg + a.in[10][h * 128];
        YA[row * 1024 + col] = f2bf(bf2f(U[row * 512 + col]) * mix);
    }
    {
        const int qh = w, kvh = qh >> 2;
        float qv[64];
#pragma unroll
        for (int i = 0; i < 8; ++i) { const u32x4 qq = *(const u32x4*)(Q + row * 512 + qh * 64 + i * 8);
#pragma unroll
            for (int k = 0; k < 4; ++k) { qv[i * 8 + 2 * k] = bflo(qq[k]); qv[i * 8 + 2 * k + 1] = bfhi(qq[k]); } }
        const float* ck = a.in[2] + ((size_t)bs * 128) * 128 + kvh * 64;
        const float* cv = a.in[3] + ((size_t)bs * 128) * 128 + kvh * 64;
        float s0 = 0.f, s1 = 0.f, sn = 0.f;
#pragma unroll
        for (int i = 0; i < 16; ++i) {
            const f32x4 k0 = *(const f32x4*)(ck + (size_t)lane * 128 + 4 * i), k1 = *(const f32x4*)(ck + (size_t)(lane + 64) * 128 + 4 * i);
#pragma unroll
            for (int k = 0; k < 4; ++k) { s0 += qv[4 * i + k] * k0[k]; s1 += qv[4 * i + k] * k1[k]; }
        }
#pragma unroll
        for (int i = 0; i < 8; ++i) { const u32x4 kk = *(const u32x4*)(KB + row * 128 + kvh * 64 + i * 8);
#pragma unroll
            for (int k = 0; k < 4; ++k) sn += qv[i * 8 + 2 * k] * bflo(kk[k]) + qv[i * 8 + 2 * k + 1] * bfhi(kk[k]); }
        const float sink2 = a.in[11][qh] * LOG2E;
        float mx = wave_max(fmaxf(s0, s1)); mx = fmaxf(fmaxf(mx, sn), sink2);
        const float p0 = __builtin_amdgcn_exp2f(s0 - mx), p1 = __builtin_amdgcn_exp2f(s1 - mx), pn = __builtin_amdgcn_exp2f(sn - mx);
        const float denom = wave_sum(p0 + p1) + pn + __builtin_amdgcn_exp2f(sink2 - mx);
        float* P = (float*)(lds + 1024) + w * 128;
        P[lane] = p0; P[lane + 64] = p1;
        __syncthreads();
        float o = pn * bf2f(VB[row * 128 + kvh * 64 + lane]);
#pragma unroll 8
        for (int j = 0; j < 128; ++j) o += P[j] * cv[(size_t)j * 128 + lane];
        YB[row * 1024 + qh * 64 + lane] = f2bf(o / denom);
    }
    __syncthreads();
}

__device__ __forceinline__ f32x4 fixup_item(const float* HEAD, const float* TAIL, const float* cw, const float* cb, long e, size_t& oidx) {
    const int cg4 = (int)(e % 768), rr = (int)(e / 768) & 1, blk = (int)(e / 1536);
    const int col = cg4 * 4; oidx = ((size_t)blk * 64 + rr) * 3072 + col;
    const bool first = ((blk * 64) & 2047) == 0;
    f32x4 cc[2];
#pragma unroll
    for (int hf = 0; hf < 2; ++hf) {
        const int ac = hf * 3072 + col;
        const f32x4 w0 = *(const f32x4*)(cw + ac), w1 = *(const f32x4*)(cw + 6144 + ac), w2 = *(const f32x4*)(cw + 12288 + ac), b0 = *(const f32x4*)(cb + ac);
        const f32x4 h0 = *(const f32x4*)(HEAD + ((size_t)blk * 2 + 0) * 6144 + ac), h1 = *(const f32x4*)(HEAD + ((size_t)blk * 2 + 1) * 6144 + ac);
        const int pb = first ? blk : blk - 1;
        f32x4 t0 = *(const f32x4*)(TAIL + ((size_t)pb * 2 + 0) * 6144 + ac), t1 = *(const f32x4*)(TAIL + ((size_t)pb * 2 + 1) * 6144 + ac);
        if (first) { t0 = (f32x4){0.f, 0.f, 0.f, 0.f}; t1 = t0; }
        cc[hf] = rr == 0 ? (b0 + w0 * t0 + w1 * t1 + w2 * h0) : (b0 + w0 * t1 + w1 * h0 + w2 * h1);
    }
    f32x4 r;
#pragma unroll
    for (int j = 0; j < 4; ++j) r[j] = gelu_t(cc[0][j]) * cc[1][j];
    return r;
}
__device__ __forceinline__ void conv_fixup(const Args& a, int G) {
    unsigned char* ws = a.ws;
    const float* HEAD = (const float*)(ws + WS_HEAD); const float* TAIL = (const float*)(ws + WS_TAIL); bf16_t* ACT = (bf16_t*)(ws + WS_ACT);
    const float* cw = a.in[17]; const float* cb = a.in[18];
    const long gt = (long)blockIdx.x * 512 + threadIdx.x, NT = (long)G * 512, NE = 512L * 2 * 768;
    for (long e0 = gt; e0 < NE; e0 += 3 * NT) {
        f32x4 r[3]; size_t oi[3]; bool okq[3];
#pragma unroll
        for (int q = 0; q < 3; ++q) { const long e = e0 + q * NT; okq[q] = e < NE; r[q] = fixup_item(HEAD, TAIL, cw, cb, okq[q] ? e : e0, oi[q]); }
#pragma unroll
        for (int q = 0; q < 3; ++q) if (okq[q]) *(u32x2*)(ACT + oi[q]) = pack4(r[q]);
    }
}
__device__ __forceinline__ void final_norm(const Args& a, int vcu, int G) {
    const int tid = threadIdx.x, lane = tid & 63, wave = tid >> 6;
    const float* ssq2 = (const float*)(a.ws + WS_SSQ2); const float* g = a.in[20]; const bf16_t* X2B = (const bf16_t*)(a.ws + WS_X2B);
    f32x4 gg[4];
#pragma unroll
    for (int j = 0; j < 4; ++j) gg[j] = ((const f32x4*)g)[64 * j + lane];
    for (int ch = vcu * 8 + wave; ch < MTOT / 4; ch += G * 8) {
        const int rowc = ch * 4;
        u32x2 v[4][4]; float sq[4];
#pragma unroll
        for (int r = 0; r < 4; ++r) {
            sq[r] = ssq2[(size_t)(rowc + r) * 16 + (lane & 15)];
#pragma unroll
            for (int j = 0; j < 4; ++j) v[r][j] = __builtin_nontemporal_load(((const u32x2*)(X2B + (size_t)(rowc + r) * 1024)) + 64 * j + lane);
        }
#pragma unroll
        for (int r = 0; r < 4; ++r) {
            float s = sq[r];
            s += __shfl_xor(s, 1); s += __shfl_xor(s, 2); s += __shfl_xor(s, 4); s += __shfl_xor(s, 8);
            const float rstd = rsqrtf(s * (1.f / 1024.f) + EPSN);
#pragma unroll
            for (int j = 0; j < 4; ++j) __builtin_nontemporal_store(unpack4(v[r][j]) * rstd * gg[j], ((f32x4*)(a.out + (size_t)(rowc + r) * 1024)) + 64 * j + lane);
        }
    }
}

__device__ __forceinline__ void skinny_tile(const bf16_t* A, int lda, const bf16_t* Bt, int ldb, int K, int row0, int colA0, int colB0, float* red, float* tile) {
    const int tid = threadIdx.x, lane = tid & 63, w = __builtin_amdgcn_readfirstlane(tid >> 6), l15 = lane & 15, lg = lane >> 4;
    f32x4 acc[4];
#pragma unroll
    for (int n = 0; n < 4; ++n) acc[n] = (f32x4){0.f, 0.f, 0.f, 0.f};
    const bf16_t* ap = A + (size_t)(row0 + l15) * lda + 8 * lg;
    const bf16_t* bp0 = Bt + (size_t)(colA0 + l15) * ldb + 8 * lg;
    const bf16_t* bp1 = Bt + (size_t)(colA0 + 16 + l15) * ldb + 8 * lg;
    const bf16_t* bp2 = Bt + (size_t)(colB0 + l15) * ldb + 8 * lg;
    const bf16_t* bp3 = Bt + (size_t)(colB0 + 16 + l15) * ldb + 8 * lg;
    const int nks = K >> 5;
#pragma unroll 2
    for (int ks = w; ks < nks; ks += 8) {
        const bf16x8 Af = *(const bf16x8*)(ap + 32 * ks);
        const bf16x8 B0 = *(const bf16x8*)(bp0 + 32 * ks), B1 = *(const bf16x8*)(bp1 + 32 * ks), B2 = *(const bf16x8*)(bp2 + 32 * ks), B3 = *(const bf16x8*)(bp3 + 32 * ks);
        acc[0] = mfma16(Af, B0, acc[0]); acc[1] = mfma16(Af, B1, acc[1]); acc[2] = mfma16(Af, B2, acc[2]); acc[3] = mfma16(Af, B3, acc[3]);
    }
    __syncthreads();
#pragma unroll
    for (int n = 0; n < 4; ++n)
#pragma unroll
        for (int r = 0; r < 4; ++r) red[w * 1024 + (4 * lg + r) * 64 + 16 * n + l15] = acc[n][r];
    __syncthreads();
#pragma unroll
    for (int h = 0; h < 2; ++h) { const int e = tid + 512 * h; float s = 0.f;
#pragma unroll
        for (int k = 0; k < 8; ++k) s += red[k * 1024 + e];
        tile[e] = s; }
    __syncthreads();
}
__device__ __forceinline__ void sample_p3(const Args& a, unsigned char* lds, int G) {
    unsigned char* ws = a.ws; float* red = (float*)lds; float* tA = (float*)(lds + 32768); float* tB = (float*)(lds + 36864);
    const bf16_t* SA = (const bf16_t*)(ws + WS_SA); const bf16_t* SB = (const bf16_t*)(ws + WS_SB); bf16_t* MG = (bf16_t*)(ws + WS_MG);
    for (int p = blockIdx.x; p < 128; p += G) {
        const int rg = p & 7, cgp = p >> 3, row0 = MP + 16 * rg, col0 = 64 * cgp;
        skinny_tile((const bf16_t*)(ws + WS_Y), 1024, (const bf16_t*)(ws + WS_WPA), 1024, 512, row0, col0, col0 + 32, red, tA);
        skinny_tile((const bf16_t*)(ws + WS_Y) + 512, 1024, (const bf16_t*)(ws + WS_WPA) + 512, 1024, 512, row0, col0, col0 + 32, red, tB);
#pragma unroll
        for (int h = 0; h < 2; ++h) { const int e = threadIdx.x + 512 * h; const size_t off = (size_t)(row0 + (e >> 6)) * 1024 + col0 + (e & 63);
            MG[off] = f2bf(bf2f(SB[off]) * (bf2f(SA[off]) * tA[e] + tB[e])); }
    }
}
__device__ __forceinline__ void sample_res(const Args& a, unsigned char* lds, int G, const bf16_t* A, int K, const bf16_t* Bt, const float* basef, const bf16_t* baseb, bf16_t* XB, float* ssq) {
    float* red = (float*)lds; float* tl = (float*)(lds + 32768);
    for (int p = blockIdx.x; p < 128; p += G) {
        const int rg = p & 7, cgp = p >> 3, row0 = MP + 16 * rg, col0 = 64 * cgp;
        skinny_tile(A, K, Bt, K, K, row0, col0, col0 + 32, red, tl);
#pragma unroll
        for (int h = 0; h < 2; ++h) { const int e = threadIdx.x + 512 * h; const int row = row0 + (e >> 6), col = col0 + (e & 63);
            const float bs = baseb ? bf2f(baseb[(size_t)row * 1024 + col]) : basef[(size_t)(row - MP) * 1024 + col];
            const float v = bs + tl[e];
            XB[(size_t)row * 1024 + col] = f2bf(v);
            const float q = wave_sum(v * v);
            if ((threadIdx.x & 63) == 0) ssq[(size_t)row * 16 + cgp] = q; }
    }
}
__device__ __forceinline__ void sample_up(const Args& a, unsigned char* lds, int G) {
    unsigned char* ws = a.ws; float* red = (float*)lds; float* tl = (float*)(lds + 32768);
    const float* ssq1 = (const float*)(ws + WS_SSQ1); const float* cw = a.in[17]; const float* cb = a.in[18]; const float* st = a.in[4]; bf16_t* ACT = (bf16_t*)(ws + WS_ACT);
    for (int p = blockIdx.x; p < 768; p += G) {
        const int rg = p & 7, rest = p >> 3, qq = rest & 3, pn = rest >> 2, row0 = MP + 16 * rg;
        skinny_tile((const bf16_t*)(ws + WS_X1B), 1024, (const bf16_t*)(ws + WS_WUP), 1024, 1024, row0, 256 * pn + 32 * qq, 256 * pn + 128 + 32 * qq, red, tl);
        const int t = threadIdx.x, r = t >> 5, c = t & 31, row = row0 + r, bs = row - MP, ac = 128 * pn + 32 * qq + c, bc = 3072 + ac;
        float ss = 0.f;
#pragma unroll
        for (int k = 0; k < 16; ++k) ss += ssq1[(size_t)row * 16 + k];
        const float rstd = rsqrtf(ss * (1.f / 1024.f) + EPSN);
        const float za = tl[r * 64 + c] * rstd, zb = tl[r * 64 + 32 + c] * rstd;
        a.out[O_CS + ((size_t)bs * 2 + 1) * 6144 + ac] = za; a.out[O_CS + ((size_t)bs * 2 + 1) * 6144 + bc] = zb;
        const float ca = cb[ac] + cw[ac] * st[((size_t)bs * 2) * 6144 + ac] + cw[6144 + ac] * st[((size_t)bs * 2 + 1) * 6144 + ac] + cw[12288 + ac] * za;
        const float cb2 = cb[bc] + cw[bc] * st[((size_t)bs * 2) * 6144 + bc] + cw[6144 + bc] * st[((size_t)bs * 2 + 1) * 6144 + bc] + cw[12288 + bc] * zb;
        ACT[(size_t)row * 3072 + ac] = f2bf(gelu_t(ca) * cb2);
    }
}

#define XB_TMO      128
#define XB_XCNT(j)  (256  + 64 * (j))
#define XB_XSUB(j)  (1280 + 64 * (j))
#define XB_XGEN(j)  (2304 + 64 * (j))
#define XB_TOP      3328
#define XB_TOPGEN   3392
#define XCD_BAR_WORDS 3456
#define XB_SPIN_CAP (1u << 18)

__device__ __forceinline__ unsigned xb_ld(unsigned* p)              { return __hip_atomic_load(p, __ATOMIC_RELAXED, __HIP_MEMORY_SCOPE_AGENT); }
__device__ __forceinline__ unsigned xb_add(unsigned* p, unsigned v) { return __hip_atomic_fetch_add(p, v, __ATOMIC_RELAXED, __HIP_MEMORY_SCOPE_AGENT); }
__device__ __forceinline__ unsigned xb_xcc_id() { return (unsigned)__builtin_amdgcn_s_getreg((3 << 11) | 20) & 0xFu; }
#define XB_SPIN(cond, bar) do { unsigned _sp = 0; while (cond) { __builtin_amdgcn_s_sleep(1); \
    if ((++_sp & 255u) == 0u) { if (xb_ld(&(bar)[XB_TMO])) break; if (_sp > XB_SPIN_CAP) { atomicAdd(&(bar)[XB_TMO], 1u); break; } } } } while (0)

struct XcdBarrier {
    unsigned* bar; unsigned x;
    volatile LAS unsigned* st;
};

__device__ __forceinline__ XcdBarrier xcd_barrier_post(unsigned* bar, volatile LAS unsigned* st) {
    XcdBarrier b; b.bar = bar; b.x = xb_xcc_id(); b.st = st;
    if (threadIdx.x == 0) (void)xb_add(&bar[XB_XCNT(b.x)], 1u);
    return b;
}
__device__ __forceinline__ void xcd_barrier_complete(unsigned* bar, unsigned x, unsigned& nloc, unsigned& nx) {
    const unsigned G = gridDim.x * gridDim.y * gridDim.z;
    unsigned sum, cnt, mine, sp = 0u;
    for (;;) {
        sum = 0u; cnt = 0u; mine = 0u;
#pragma unroll
        for (unsigned j = 0; j < 16; ++j) { const unsigned c = xb_ld(&bar[XB_XCNT(j)]); sum += c; cnt += (c > 0u) ? 1u : 0u; mine = (j == x) ? c : mine; }
        if (sum == G) break;
        __builtin_amdgcn_s_sleep(1);
        if ((++sp & 255u) == 0u) { if (xb_ld(&bar[XB_TMO])) break; if (sp > XB_SPIN_CAP) { atomicAdd(&bar[XB_TMO], 1u); break; } }
    }
    nloc = mine > 0u ? mine : 1u; nx = cnt > 0u ? cnt : 1u;
}

__device__ __forceinline__ void xcd_barrier(const XcdBarrier& b) {
    asm volatile("s_waitcnt vmcnt(0)" ::: "memory");
    __syncthreads();
    if (threadIdx.x == 0) {
        unsigned* bar = b.bar;
        __builtin_amdgcn_s_waitcnt(0);
        unsigned nloc = b.st[0], nx = b.st[1];
        if (nloc == 0u) { xcd_barrier_complete(bar, b.x, nloc, nx); b.st[0] = nloc; b.st[1] = nx; }
        const unsigned old = xb_add(&bar[XB_XSUB(b.x)], 1u);
        const unsigned gen = old / nloc;
        if (old + 1u == (gen + 1u) * nloc) {
            __builtin_amdgcn_fence(__ATOMIC_RELEASE, "agent");
            asm volatile("s_waitcnt vmcnt(0)" ::: "memory");
            const unsigned og = xb_add(&bar[XB_TOP], 1u);
            const unsigned tg = og / nx;
            if (og + 1u == (tg + 1u) * nx) xb_add(&bar[XB_TOPGEN], 1u);
            else XB_SPIN(xb_ld(&bar[XB_TOPGEN]) == tg, bar);
            __builtin_amdgcn_fence(__ATOMIC_ACQUIRE, "agent");
            xb_add(&bar[XB_XGEN(b.x)], 1u);
            asm volatile("s_waitcnt vmcnt(0)" ::: "memory");
        } else {
            XB_SPIN(xb_ld(&bar[XB_XGEN(b.x)]) == gen, bar);
            __builtin_amdgcn_fence(__ATOMIC_ACQUIRE, "agent");
            asm volatile("s_waitcnt vmcnt(0)" ::: "memory");
        }
    }
    __syncthreads();
}

__global__ void __launch_bounds__(512, 2) fwd_mega(Args a) {
    extern __shared__ __attribute__((aligned(16))) unsigned char lds[];
    cg::grid_group grid = cg::this_grid();
    LAS unsigned char* ldsl = (LAS unsigned char*)lds;
    const int G = gridDim.x, bx = blockIdx.x;
    const int vcu = (G % 8 == 0) ? (bx % 8) * (G / 8) + bx / 8 : bx;
    unsigned char* ws = a.ws;
    bf16_t* XN = (bf16_t*)(ws + WS_XN); bf16_t* Ub = (bf16_t*)(ws + WS_U); bf16_t* AVb = (bf16_t*)(ws + WS_AV); bf16_t* Qb = (bf16_t*)(ws + WS_Q);
    bf16_t* KBb = (bf16_t*)(ws + WS_KB); bf16_t* VBb = (bf16_t*)(ws + WS_VB); bf16_t* SAb = (bf16_t*)(ws + WS_SA); bf16_t* SBb = (bf16_t*)(ws + WS_SB);
    bf16_t* MGb = (bf16_t*)(ws + WS_MG);
    bf16_t* X1B = (bf16_t*)(ws + WS_X1B); bf16_t* ACTb = (bf16_t*)(ws + WS_ACT);
    float* SSQ1 = (float*)(ws + WS_SSQ1); float* SSQ2 = (float*)(ws + WS_SSQ2);

    volatile LAS unsigned* MISC = (volatile LAS unsigned*)(ldsl + LDS_BYTES - 64);
    if (threadIdx.x < 16) MISC[threadIdx.x] = 0u;
    unsigned* barw = (unsigned*)ws;
    __syncthreads();
    XcdBarrier bar = xcd_barrier_post(barw, MISC);
    if (a.dbg) grid.sync();
    p0_prologue(a, ldsl, 0, vcu, G);
    xcd_barrier(bar);
    {
        pg8::Gemm g{XN, (const bf16_t*)(ws + WS_WIN), MPAD, NIN, 1024}; pg8::StaticOrder S; S.init(MPAD, NIN, G, bx);
        EpiIn E{Ub, AVb, Qb, KBb, VBb, SAb, SBb, (const float*)(ws + WS_ROPE), a.out};
        pg8::gemm_phase<EpiIn, pg8::StaticOrder, true, true>(ldsl, g, S, E);
    }
    {
        const int nwg1 = (MPAD / 256) * (NIN / 256), nfull = nwg1 % G;
        if (nfull == 0) p0_prologue(a, ldsl, 1, bx, G); else if (bx >= nfull) p0_prologue(a, ldsl, 1, bx - nfull, G - nfull);
    }
    xcd_barrier(bar);
    for (int unit = bx; unit < 256; unit += G) mixer_prompt_unit(a, lds, unit >> 4, unit & 15);
    for (int tk = bx; tk < MS; tk += G) mixer_sample_token(a, lds, tk);
    xcd_barrier(bar);
    {
    {
        pg8::Gemm g{(const bf16_t*)(ws + WS_Y), (const bf16_t*)(ws + WS_WPA), MP, 1024, 512, 1024, 1024}; pg8::SplitOrder S; S.init(MP, 1024, G, bx);
        EpiGate E{SAb, SBb, MGb};
        pg8::gemm_phase<EpiGate, pg8::SplitOrder, true, true>(ldsl, g, S, E);
    }
    sample_p3(a, lds, G);
    }
    xcd_barrier(bar);
    {
        pg8::Gemm g{MGb, (const bf16_t*)(ws + WS_WO), MP, 1024, 1024}; pg8::StaticOrder S; S.init(MP, 1024, G, bx);
        EpiRes E{a.in[0], nullptr, X1B, SSQ1};
        pg8::gemm_phase<EpiRes, pg8::StaticOrder, true, true>(ldsl, g, S, E);
        sample_res(a, lds, G, MGb, 1024, (const bf16_t*)(ws + WS_WO), a.in[1], nullptr, X1B, SSQ1);
    }
    xcd_barrier(bar);
    {
        pg8::Gemm g{X1B, (const bf16_t*)(ws + WS_WUP), MP, NUP, 1024}; pg8::StaticOrder S; S.init(MP, NUP, G, bx);
        EpiUp E{SSQ1, a.in[17], a.in[18], ACTb, (float*)(ws + WS_HEAD), (float*)(ws + WS_TAIL), a.out, (LAS float*)(ldsl + 131072)};
        pg8::gemm_phase<EpiUp, pg8::StaticOrder, true, true>(ldsl, g, S, E);
        sample_up(a, lds, G);
    }
    xcd_barrier(bar);
    conv_fixup(a, G);
    xcd_barrier(bar);
    {
        pg8::Gemm g{ACTb, (const bf16_t*)(ws + WS_WDN), MP, 1024, 3072}; pg8::StaticOrder S; S.init(MP, 1024, G, bx);
        EpiRes E{nullptr, X1B, (bf16_t*)(ws + WS_X2B), SSQ2};
        pg8::gemm_phase<EpiRes, pg8::StaticOrder, true, true>(ldsl, g, S, E);
        sample_res(a, lds, G, ACTb, 3072, (const bf16_t*)(ws + WS_WDN), nullptr, X1B, (bf16_t*)(ws + WS_X2B), SSQ2);
    }
    xcd_barrier(bar);
    final_norm(a, vcu, G);
}

extern "C" void kernel_launch(void* const* d_in, const int* in_sizes, int n_in, void* d_out, int out_size, void* d_ws, size_t ws_size, hipStream_t stream) {
    static int grid = 0;
    if (grid == 0) {
        if (n_in != 21 || out_size != (int)O_END || ws_size < WS_END) { fprintf(stderr, "kernel_launch: unexpected shapes n_in %d out %d ws %zu\n", n_in, out_size, ws_size); grid = -1; return; }
        int dev = 0, cus = 0, per_cu = 0;
        if (hipGetDevice(&dev) != hipSuccess || hipDeviceGetAttribute(&cus, hipDeviceAttributeMultiprocessorCount, dev) != hipSuccess) { grid = -1; return; }
        if (hipFuncSetAttribute((const void*)fwd_mega, hipFuncAttributeMaxDynamicSharedMemorySize, LDS_BYTES) != hipSuccess) { grid = -1; return; }
        if (hipOccupancyMaxActiveBlocksPerMultiprocessor(&per_cu, (const void*)fwd_mega, 512, LDS_BYTES) != hipSuccess || per_cu < 1) { fprintf(stderr, "occupancy query: %d\n", per_cu); }
        (void)hipGetLastError();
        grid = cus;
    }
    if (grid < 0) return;
    if (hipMemsetAsync(d_ws, 0, 32768, stream) != hipSuccess) { fprintf(stderr, "kernel_launch: memset failed\n"); return; }
    Args a{};
    for (int i = 0; i < 21; ++i) a.in[i] = (const float*)d_in[i];
    a.out = (float*)d_out; a.ws = (unsigned char*)d_ws; a.dbg = 0; a.pad = 0;
    void* args[] = {&a};
    hipError_t e = hipLaunchCooperativeKernel((void*)fwd_mega, dim3(grid), dim3(512), args, LDS_BYTES, stream);
    if (e != hipSuccess) fprintf(stderr, "cooperative launch failed: %s (grid %d)\n", hipGetErrorString(e), grid);
}
```
